# Optimizing an MI355X kernel written in HIP

```python
import math
import jax, jax.numpy as jnp
from jax import lax
import numpy as np

D_MODEL = 1024
BATCH = 4
SEQ = 8192
DEPTH = 1
DEC_BATCH = 32
DEC_SEQ = 4
PAST_LEN = 16384
PAGE_SIZE = 128

A_GROUPS = ((128, 1), (512, 4), (2048, 16))
N_A_GROUPS = len(A_GROUPS)
A_HEADS = 8
A_HEAD_DIM = 64
A_OUT = A_HEADS * A_HEAD_DIM
B_D_INNER = (3 * D_MODEL) // 2
B_HEAD_DIM = 64
B_HEADS = B_D_INNER // B_HEAD_DIM
B_GROUPS = 4
B_D_STATE = 128
B_CONV = 4
B_CHUNK = 128
B_CONV_DIM = B_D_INNER + 2 * B_GROUPS * B_D_STATE
D_FF = ((8 * D_MODEL // 3 + 127) // 128) * 128
RMS_EPS = 1e-6

OFF_A = 0
OFF_Z = OFF_A + N_A_GROUPS * 3 * A_OUT
OFF_XBC = OFF_Z + B_D_INNER
OFF_DT = OFF_XBC + B_CONV_DIM
OFF_GATE = OFF_DT + B_HEADS
N_IN_COLS = OFF_GATE + 2 * D_MODEL

kernel_name = "dilated_attn_ssd_gated_hybrid_step"


def rmsnorm(x, g):
    xf = x.astype(jnp.float32)
    y = xf * lax.rsqrt(jnp.mean(xf * xf, axis=-1, keepdims=True) + RMS_EPS)
    return (y * g.astype(jnp.float32)).astype(x.dtype)


def swiglu(x, wg, wu, wd):
    return (jax.nn.silu(x @ wg) * (x @ wu)) @ wd


def dilated_attn_prompt(q, k, v, window, dil):
    b, s, h, e = q.shape
    nw = window // dil
    ls = s // dil
    nb = -(-ls // nw)
    pad = nb * nw - ls

    def to_blocks(t):
        t = t.reshape(b, ls, dil, h, e).transpose(0, 2, 1, 3, 4)
        t = jnp.pad(t, ((0, 0), (0, 0), (0, pad), (0, 0), (0, 0)))
        return t.reshape(b, dil, nb, nw, h, e)

    def with_prev(t):
        prev = jnp.pad(t, ((0, 0), (0, 0), (1, 0), (0, 0), (0, 0), (0, 0)))[:, :, :nb]
        return jnp.concatenate([prev, t], axis=3)

    qb = to_blocks(q)
    kb = with_prev(to_blocks(k))
    vb = with_prev(to_blocks(v))
    scores = jnp.einsum("brnqhe,brnkhe->brnhqk", qb, kb).astype(jnp.float32) * (A_HEAD_DIM ** -0.5)
    qi = jnp.arange(nw)[:, None]
    kj = jnp.arange(2 * nw)[None, :]
    dist = qi + nw - kj
    blk = jnp.arange(nb)[:, None, None]
    valid = (dist >= 0) & (dist <= nw) & ((blk > 0) | (kj >= nw))
    scores = jnp.where(valid[None, None, :, None], scores, -jnp.inf)
    m = jnp.max(scores, axis=-1, keepdims=True)
    pr = jnp.exp(scores - m)
    den = jnp.sum(pr, axis=-1)
    o = jnp.einsum("brnhqk,brnkhe->brnqhe", pr, vb.astype(jnp.float32))
    o = o / jnp.moveaxis(den, -1, -2)[..., None]
    lse = jnp.moveaxis(m[..., 0] + jnp.log(den), -1, -2)

    def from_blocks(t):
        t = t.reshape((b, dil, nb * nw) + t.shape[4:])[:, :, :ls]
        t = jnp.moveaxis(t, 1, 2)
        return t.reshape((b, s) + t.shape[3:])

    return from_blocks(o), from_blocks(lse)


def dilated_attn_sample(q, k, v, kv_buf, window, dil):
    b, l, h, e = q.shape
    lb = kv_buf.shape[1]
    nw = window // dil
    kv = jnp.concatenate([kv_buf, jnp.stack([k, v], axis=2).astype(kv_buf.dtype)], axis=1)
    idx = lb + jnp.arange(l)[:, None] - dil * jnp.arange(nw + 1)[None, :]
    valid = idx >= 0
    idx = jnp.maximum(idx, 0)
    kg = kv[:, :, 0][:, idx]
    vg = kv[:, :, 1][:, idx]
    scores = jnp.einsum("blhe,bljhe->blhj", q, kg).astype(jnp.float32) * (A_HEAD_DIM ** -0.5)
    scores = jnp.where(valid[None, :, None, :], scores, -jnp.inf)
    m = jnp.max(scores, axis=-1, keepdims=True)
    pr = jnp.exp(scores - m)
    den = jnp.sum(pr, axis=-1)
    o = jnp.einsum("blhj,bljhe->blhe", pr, vg.astype(jnp.float32)) / den[..., None]
    lse = m[..., 0] + jnp.log(den)
    new_buf = kv[:, -min(window, lb + l):]
    return o, lse, new_buf


def causal_conv(xbc, buf, w, bias):
    l = xbc.shape[1]
    xp = jnp.concatenate([buf.astype(xbc.dtype), xbc], axis=1)
    y = bias
    for tap in range(B_CONV):
        y = y + xp[:, tap:tap + l] * w[tap]
    return jax.nn.silu(y), xp[:, -(B_CONV - 1):]


def ssd_chunked(x, dt, a_neg, bm, cm, init_state):
    f32 = jnp.float32
    b, l, nh, hp = x.shape
    rep = nh // B_GROUPS
    t = min(B_CHUNK, l)
    nc = -(-l // t)
    pad = nc * t - l

    def padt(a):
        return jnp.pad(a, [(0, 0), (0, pad)] + [(0, 0)] * (a.ndim - 2))

    xd = padt((x.astype(f32) * dt[..., None])).reshape(b, nc, t, B_GROUPS, rep, hp)
    da = padt(dt * a_neg).reshape(b, nc, t, B_GROUPS, rep)
    bc = padt(bm.astype(f32)).reshape(b, nc, t, B_GROUPS, B_D_STATE)
    cc = padt(cm.astype(f32)).reshape(b, nc, t, B_GROUPS, B_D_STATE)
    cs = jnp.cumsum(da, axis=2)
    seg = cs[:, :, :, None] - cs[:, :, None, :]
    causal = jnp.tril(jnp.ones((t, t), bool))[None, None, :, :, None, None]
    lmat = jnp.exp(jnp.where(causal, seg, -jnp.inf))
    cb = jnp.einsum("bcign,bcjgn->bcijg", cc, bc)
    y_diag = jnp.einsum("bcijgr,bcjgrp->bcigrp", cb[..., None] * lmat, xd)
    decay_to_end = jnp.exp(cs[:, :, -1:] - cs)
    chunk_states = jnp.einsum("bcjgn,bcjgrp->bcgrpn", bc, xd * decay_to_end[..., None])
    chunk_decay = jnp.exp(cs[:, :, -1])

    def step(s, inp):
        dec, st = inp
        return s * dec[..., None, None] + st, s

    s0 = init_state.astype(f32).reshape(b, B_GROUPS, rep, hp, B_D_STATE)
    final, prev = lax.scan(step, s0, (jnp.moveaxis(chunk_decay, 1, 0), jnp.moveaxis(chunk_states, 1, 0)))
    prev = jnp.moveaxis(prev, 0, 1)
    y_off = jnp.einsum("bcign,bcgrpn->bcigrp", cc, prev) * jnp.exp(cs)[..., None]
    y = (y_diag + y_off).reshape(b, nc * t, nh, hp)[:, :l]
    return y, final.reshape(b, nh, hp, B_D_STATE)


def token_mixer(hn, kv_bufs, conv_buf, ssm_state, p):
    f32 = jnp.float32
    b, l, _ = hn.shape
    proj = hn @ p["w_in"]
    qkv = proj[..., OFF_A:OFF_Z].reshape(b, l, N_A_GROUPS, 3, A_HEADS, A_HEAD_DIM)
    outs, lses, new_kv = [], [], []
    for g, (window, dil) in enumerate(A_GROUPS):
        q, k, v = qkv[:, :, g, 0], qkv[:, :, g, 1], qkv[:, :, g, 2]
        if kv_bufs is None:
            o, lse = dilated_attn_prompt(q, k, v, window, dil)
            kv_new = jnp.stack([k, v], axis=2)[:, -min(window, l):]
        else:
            o, lse, kv_new = dilated_attn_sample(q, k, v, kv_bufs[g], window, dil)
        outs.append(o)
        lses.append(lse)
        new_kv.append(kv_new)
    alpha = jax.nn.softmax(jnp.stack(lses, axis=2), axis=2)
    o_a = jnp.sum(alpha[..., None] * jnp.stack(outs, axis=2), axis=2)
    o_a = o_a.reshape(b, l, A_OUT).astype(hn.dtype) @ p["w_branch_a"]
    z = proj[..., OFF_Z:OFF_XBC]
    xbc, new_conv = causal_conv(proj[..., OFF_XBC:OFF_DT], conv_buf, p["conv_w"], p["conv_b"])
    xs = xbc[..., :B_D_INNER].reshape(b, l, B_HEADS, B_HEAD_DIM)
    bm = xbc[..., B_D_INNER:B_D_INNER + B_GROUPS * B_D_STATE].reshape(b, l, B_GROUPS, B_D_STATE)
    cm = xbc[..., B_D_INNER + B_GROUPS * B_D_STATE:].reshape(b, l, B_GROUPS, B_D_STATE)
    dt = jax.nn.softplus(proj[..., OFF_DT:OFF_GATE].astype(f32) + p["dt_bias"].astype(f32))
    a_neg = -jnp.exp(p["a_log"].astype(f32))
    y, new_ssm = ssd_chunked(xs, dt, a_neg, bm, cm, ssm_state)
    y = y + xs.astype(f32) * p["d_skip"].astype(f32)[:, None]
    y = y.reshape(b, l, B_D_INNER) * jax.nn.silu(z.astype(f32))
    yg = y.reshape(b, l, B_GROUPS, B_D_INNER // B_GROUPS)
    yg = yg * lax.rsqrt(jnp.mean(yg * yg, axis=-1, keepdims=True) + RMS_EPS)
    y = yg.reshape(b, l, B_D_INNER) * p["ssd_norm_w"].astype(f32)
    o_b = y.astype(hn.dtype) @ p["w_branch_b"]
    gates = jax.nn.sigmoid(proj[..., OFF_GATE:].astype(f32))
    merged = gates[..., :D_MODEL] * o_a.astype(f32) + gates[..., D_MODEL:] * o_b.astype(f32)
    out = merged.astype(hn.dtype) @ p["w_out"]
    return out, new_kv, new_conv, new_ssm.astype(ssm_state.dtype)


def trunk_layer(x, kv_bufs, conv_buf, ssm_state, p):
    f1 = swiglu(rmsnorm(x, p["g_pre_ffn1"]), p["ffn1_gate"], p["ffn1_up"], p["ffn1_down"])
    h = x + 0.5 * rmsnorm(f1, p["g_post_ffn1"])
    mix, new_kv, new_conv, new_ssm = token_mixer(rmsnorm(h, p["g_pre_mix"]), kv_bufs, conv_buf, ssm_state, p)
    h = h + rmsnorm(mix, p["g_post_mix"])
    f2 = swiglu(rmsnorm(h, p["g_pre_ffn2"]), p["ffn2_gate"], p["ffn2_up"], p["ffn2_down"])
    h = h + 0.5 * rmsnorm(f2, p["g_post_ffn2"])
    return h, new_kv, new_conv, new_ssm


def setup_inputs(seed: int = 0) -> dict:
    key = jax.random.key(seed)
    ks = iter(jax.random.split(key, 48))
    f32 = jnp.float32
    D = D_MODEL

    def nrm(shape, scale=1.0):
        return jax.random.normal(next(ks), shape, f32) * scale

    def gain(n):
        return 1.0 + nrm((DEPTH, n), 0.02)

    inp = {}
    inp["x_prompt"] = nrm((BATCH, SEQ, D))
    inp["x_sample"] = nrm((DEC_BATCH, DEC_SEQ, D))
    for window, _ in A_GROUPS:
        inp["cache_kv_w" + str(window)] = nrm((DEPTH, DEC_BATCH, min(window, PAST_LEN), 2, A_HEADS, A_HEAD_DIM))
    inp["state_conv"] = nrm((DEPTH, DEC_BATCH, B_CONV - 1, B_CONV_DIM))
    inp["state_ssm"] = nrm((DEPTH, DEC_BATCH, B_HEADS, B_HEAD_DIM, B_D_STATE), 0.1)
    inp["w_in"] = nrm((DEPTH, D, N_IN_COLS), D ** -0.5)
    inp["conv_w"] = nrm((DEPTH, B_CONV, B_CONV_DIM), B_CONV ** -0.5)
    inp["conv_b"] = nrm((DEPTH, B_CONV_DIM), 0.01)
    u = jax.random.uniform(next(ks), (DEPTH, B_HEADS), f32)
    dt0 = jnp.exp(u * (math.log(0.1) - math.log(0.001)) + math.log(0.001))
    inp["dt_bias"] = dt0 + jnp.log(-jnp.expm1(-dt0))
    inp["a_log"] = jnp.log(jax.random.uniform(next(ks), (DEPTH, B_HEADS), f32, 1.0, 16.0))
    inp["d_skip"] = 1.0 + nrm((DEPTH, B_HEADS), 0.1)
    inp["ssd_norm_w"] = gain(B_D_INNER)
    inp["w_branch_a"] = nrm((DEPTH, A_OUT, D), A_OUT ** -0.5)
    inp["w_branch_b"] = nrm((DEPTH, B_D_INNER, D), B_D_INNER ** -0.5)
    inp["w_out"] = nrm((DEPTH, D, D), D ** -0.5)
    inp["ffn1_gate"] = nrm((DEPTH, D, D_FF), D ** -0.5)
    inp["ffn1_up"] = nrm((DEPTH, D, D_FF), D ** -0.5)
    inp["ffn1_down"] = nrm((DEPTH, D_FF, D), D_FF ** -0.5)
    inp["ffn2_gate"] = nrm((DEPTH, D, D_FF), D ** -0.5)
    inp["ffn2_up"] = nrm((DEPTH, D, D_FF), D ** -0.5)
    inp["ffn2_down"] = nrm((DEPTH, D_FF, D), D_FF ** -0.5)
    inp["g_pre_ffn1"] = gain(D)
    inp["g_post_ffn1"] = gain(D)
    inp["g_pre_mix"] = gain(D)
    inp["g_post_mix"] = gain(D)
    inp["g_pre_ffn2"] = gain(D)
    inp["g_post_ffn2"] = gain(D)
    return inp


def reference(x_prompt, x_sample, cache_kv_w128, cache_kv_w512, cache_kv_w2048, state_conv, state_ssm,
              w_in, conv_w, conv_b, dt_bias, a_log, d_skip, ssd_norm_w, w_branch_a, w_branch_b, w_out,
              ffn1_gate, ffn1_up, ffn1_down, ffn2_gate, ffn2_up, ffn2_down,
              g_pre_ffn1, g_post_ffn1, g_pre_mix, g_post_mix, g_pre_ffn2, g_post_ffn2):
    y_p, y_s = x_prompt, x_sample
    pk128, pk512, pk2048, pconv, pssm = [], [], [], [], []
    sk128, sk512, sk2048, sconv, sssm = [], [], [], [], []
    nbp = x_prompt.shape[0]
    for layer in range(DEPTH):
        p = {"w_in": w_in[layer], "conv_w": conv_w[layer], "conv_b": conv_b[layer],
             "dt_bias": dt_bias[layer], "a_log": a_log[layer], "d_skip": d_skip[layer],
             "ssd_norm_w": ssd_norm_w[layer], "w_branch_a": w_branch_a[layer],
             "w_branch_b": w_branch_b[layer], "w_out": w_out[layer],
             "ffn1_gate": ffn1_gate[layer], "ffn1_up": ffn1_up[layer], "ffn1_down": ffn1_down[layer],
             "ffn2_gate": ffn2_gate[layer], "ffn2_up": ffn2_up[layer], "ffn2_down": ffn2_down[layer],
             "g_pre_ffn1": g_pre_ffn1[layer], "g_post_ffn1": g_post_ffn1[layer],
             "g_pre_mix": g_pre_mix[layer], "g_post_mix": g_post_mix[layer],
             "g_pre_ffn2": g_pre_ffn2[layer], "g_post_ffn2": g_post_ffn2[layer]}
        conv0 = jnp.zeros((nbp, B_CONV - 1, B_CONV_DIM), x_prompt.dtype)
        ssm0 = jnp.zeros((nbp, B_HEADS, B_HEAD_DIM, B_D_STATE), jnp.float32)
        y_p, kv_p, conv_p, ssm_p = trunk_layer(y_p, None, conv0, ssm0, p)
        bufs = (cache_kv_w128[layer], cache_kv_w512[layer], cache_kv_w2048[layer])
        y_s, kv_s, conv_s, ssm_s = trunk_layer(y_s, bufs, state_conv[layer], state_ssm[layer], p)
        pk128.append(kv_p[0]); pk512.append(kv_p[1]); pk2048.append(kv_p[2])
        pconv.append(conv_p); pssm.append(ssm_p)
        sk128.append(kv_s[0]); sk512.append(kv_s[1]); sk2048.append(kv_s[2])
        sconv.append(conv_s); sssm.append(ssm_s)
    return (y_p, y_s,
            jnp.stack(pk128), jnp.stack(pk512), jnp.stack(pk2048), jnp.stack(pconv), jnp.stack(pssm),
            jnp.stack(sk128), jnp.stack(sk512), jnp.stack(sk2048), jnp.stack(sconv), jnp.stack(sssm))
```

```cpp
#include <hip/hip_runtime.h>
#include <hip/hip_cooperative_groups.h>
#include <cstdio>
namespace cg = cooperative_groups;

#define DI __device__ __forceinline__
#define LAS __attribute__((address_space(3)))
typedef unsigned short bf16_t;
typedef short bf16x8 __attribute__((ext_vector_type(8)));
typedef short s16x4 __attribute__((ext_vector_type(4)));
typedef float f32x4 __attribute__((ext_vector_type(4)));
typedef unsigned u32x4 __attribute__((ext_vector_type(4)));
typedef unsigned u32x2 __attribute__((ext_vector_type(2)));

#ifndef SUB_MASK
#define SUB_MASK 0xff
#endif
#ifndef DOUBLE_SUB
#define DOUBLE_SUB 0
#endif
#ifndef DOUBLE_MASK
#define DOUBLE_MASK 0
#endif
#ifndef PHASE_MASK
#define PHASE_MASK 0x7fff
#endif
#ifndef N_LAUNCH_PER_PHASE
#define N_LAUNCH_PER_PHASE 0
#endif

constexpr int D = 1024, SEQ = 8192, MP = 32768, MS = 128, MROWS = MP + MS, MT = 33024;
constexpr int FF = 2816, NIN = 10776, NINP = 11008;
constexpr int OFF_Z = 4608, OFF_XBC = 6144, OFF_DT = 8704, OFF_GATE = 8728;
constexpr int LDS_BAR_OFF = 147456, LDS_BYTES = LDS_BAR_OFF + 16, NPHASE = 15;
constexpr float EPS = 1e-6f;

enum { I_XP = 0, I_XS, I_C128, I_C512, I_C2048, I_SCONV, I_SSSM, I_WIN, I_CONVW, I_CONVB, I_DTB, I_ALOG, I_DSKIP, I_NORMW, I_WA, I_WB, I_WO,
       I_G1, I_U1, I_D1, I_G2, I_U2, I_D2, I_GPRE1, I_GPOST1, I_GPREM, I_GPOSTM, I_GPRE2, I_GPOST2 };
constexpr size_t O_YP = 0, O_YS = 33554432, O_KV128P = 33685504, O_KV512P = 34209792, O_KV2048P = 36306944, O_CONVP = 44695552, O_SSMP = 44726272,
                 O_KV128S = 45512704, O_KV512S = 49707008, O_KV2048S = 66484224, O_CONVS = 133593088, O_SSMS = 133838848, O_TOTAL = 140130304;
constexpr size_t SZ_WGU = (size_t)5632 * 1024 * 2, SZ_WD = (size_t)1024 * 2816 * 2;
constexpr size_t WS_WGU1 = 0, WS_WD1 = WS_WGU1 + SZ_WGU, WS_WGU2 = WS_WD1 + SZ_WD, WS_WD2 = WS_WGU2 + SZ_WGU, WS_WIN = WS_WD2 + SZ_WD,
                 WS_WA = WS_WIN + (size_t)NINP * 1024 * 2, WS_WB = WS_WA + (size_t)1024 * 512 * 2, WS_WO = WS_WB + (size_t)1024 * 1536 * 2,
                 WS_XN = WS_WO + (size_t)1024 * 1024 * 2, WS_DTRAW = WS_XN + (size_t)MT * 1024 * 2, WS_NEWKV = WS_DTRAW + (size_t)MT * 32 * 4,
                 WS_CDEC = WS_NEWKV + (size_t)128 * 3 * 1024 * 4, WS_BAR = WS_CDEC + (size_t)4 * 64 * 24 * 4, WS_PROJ = WS_BAR + 16384,
                 WS_XBCC = WS_PROJ + (size_t)MT * NINP * 2, WS_END = WS_XBCC + (size_t)MP * 2560 * 2;
constexpr size_t WS_ACT = WS_PROJ, WS_F = WS_PROJ + 268435456;
constexpr size_t SC_ATTO = 0, SC_LSE = SC_ATTO + (size_t)MT * 1536 * 2, SC_STATES = SC_LSE + (size_t)MT * 24 * 4, SC_END = SC_STATES + (size_t)4 * 64 * 24 * 8192 * 2;
constexpr size_t SC_M1 = 0;
static_assert(SC_END <= (size_t)67108864 * 4, "scratch too big");
static_assert((size_t)MT * 1024 * 4 <= (size_t)67108864 * 4, "m1 too big");

struct Params { const float* in[29]; float* out; unsigned char* ws; int ph_lo, ph_hi; };

typedef __bf16 bf16x2_t __attribute__((ext_vector_type(2)));
typedef float f32x2_t __attribute__((ext_vector_type(2)));
DI unsigned pk2(float lo, float hi) { const f32x2_t v = {lo, hi}; const bf16x2_t b = __builtin_convertvector(v, bf16x2_t); return __builtin_bit_cast(unsigned, b); }
DI bf16_t f2bf(float x) { return (bf16_t)(pk2(x, 0.f) & 0xffffu); }
DI float bflo(unsigned u) { return __uint_as_float(u << 16); }
DI float bfhi(unsigned u) { return __uint_as_float(u & 0xffff0000u); }
DI float bf2f(bf16_t b) { return __uint_as_float(((unsigned)b) << 16); }
DI float wave_sum(float v) {
#pragma unroll
    for (int o = 1; o < 64; o <<= 1) v += __shfl_xor(v, o);
    return v; }
DI float wave_max(float v) {
#pragma unroll
    for (int o = 1; o < 64; o <<= 1) v = fmaxf(v, __shfl_xor(v, o));
    return v; }
DI float silu_f(float x) { return x * __builtin_amdgcn_rcpf(1.f + __expf(-x)); }
DI float sigmoid_f(float x) { return __builtin_amdgcn_rcpf(1.f + __expf(-x)); }
DI float softplus_f(float x) { return x > 20.f ? x : log1pf(__expf(x)); }
DI void lds_barrier() { asm volatile("s_waitcnt lgkmcnt(0)" ::: "memory"); __builtin_amdgcn_s_barrier(); asm volatile("" ::: "memory"); }
DI f32x4 mfma16(bf16x8 a, bf16x8 b, f32x4 c) { return __builtin_amdgcn_mfma_f32_16x16x32_bf16(a, b, c, 0, 0, 0); }
DI void unpack8(u32x4 v, float (&f)[8]) { f[0] = bflo(v.x); f[1] = bfhi(v.x); f[2] = bflo(v.y); f[3] = bfhi(v.y); f[4] = bflo(v.z); f[5] = bfhi(v.z); f[6] = bflo(v.w); f[7] = bfhi(v.w); }

namespace pg8 {
constexpr int BM = 256, BK = 64, HALF = 128, HTB = HALF * BK * 2, NXCD = 8, WGM = 8;
DI int lds_byte(int r, int c) { const int st = (r >> 4) * 2 + (c >> 5), rr = r & 15, cc = c & 31, ob = rr * 64 + cc * 2; return st * 1024 + (ob ^ (((ob >> 9) & 1) << 5)); }
DI void stage_rc(int b, int& R, int& C) { const int st = b / 1024, sb = b % 1024, swz = sb ^ (((sb >> 9) & 1) << 5); R = (st >> 1) * 16 + swz / 64; C = (st & 1) * 32 + (swz % 64) / 2; }
DI int perm32(int rho) { const int n = rho >> 4, i = rho & 15; return 8 * (i >> 2) + 4 * n + (i & 3); }
struct Unit { int pm, pn, kt0, ntu, split, half; };
struct Gemm { const bf16_t* A; const bf16_t* Bt; int M, N, K, lda; };
struct StaticOrder {
    int nM, nN, nwg, G, c, nt, sl;
    DI void init(int M, int N, int K, int G_, int c_, int sl_) { sl = sl_; nM = M / BM - (sl_ ? 1 : 0); nN = N / BM; nwg = nM * nN; G = G_; c = c_; nt = K / BK; }
    DI bool next(int i, Unit& u) const {
        const long L = (long)i * G + c;
        if (L >= nwg) { if (!sl) return false; const int idx = (int)(L - nwg), ns = nt / sl; if (idx >= nN * ns) return false;
            u.pm = nM; u.pn = idx % nN; u.kt0 = (idx / nN) * sl; u.ntu = sl; u.split = 1; u.half = 1; return true; }
        int wgid = (int)L; { const int q = nwg / NXCD, r = nwg % NXCD, xcd = wgid % NXCD, off = wgid / NXCD; wgid = (xcd < r ? xcd * (q + 1) : r * (q + 1) + (xcd - r) * q) + off; }
        const int nig = WGM * nN, gid = wgid / nig, fm = gid * WGM, gsz = (nM - fm) < WGM ? (nM - fm) : WGM;
        u.pm = fm + ((wgid % nig) % gsz); u.pn = (wgid % nig) / gsz; u.kt0 = 0; u.ntu = nt; u.split = 0; u.half = (u.pm == MP / BM) ? 1 : 0; return true;
    }
};
template <class Epi>
DI void gemm_phase(LAS unsigned char* lds, const Gemm g, const StaticOrder& S, const Epi& E) {
    const int tid = threadIdx.x, wid = __builtin_amdgcn_readfirstlane(tid >> 6), lane = tid & 63, wr = wid >> 2, wc = wid & 3, fr = lane & 15, fq = lane >> 4;
    const int K = g.K, lda = g.lda;
    unsigned voffA[2], voffB[2];
#pragma unroll
    for (int i = 0; i < 2; ++i) { int R, C; stage_rc(tid * 16 + i * 8192, R, C); const int Rb = Epi::PERM ? ((R & ~31) + perm32(R & 31)) : R;
        voffA[i] = (unsigned)(R * lda + C) * 2u; voffB[i] = (unsigned)(Rb * K + C) * 2u; }
    const size_t kstep = (size_t)(BK * 2);
    const size_t hstepA = (size_t)HALF * lda * 2, hstepB = (size_t)HALF * K * 2;
    const size_t tstepA = 2 * hstepA, tstepB = 2 * hstepB;
    const unsigned ldsw = (unsigned)wid * 1024u;
    const int aoff = lds_byte(wr * 64 + fr, fq * 8), boff = lds_byte(wc * 32 + fr, fq * 8);
#define PG8_SA(b, h) (((b) * 2 + (h)) * HTB)
#define PG8_SB(b, h) ((4 + (b) * 2 + (h)) * HTB)
#define PG8_STAGE(bufoff, gbase, voff) do { _Pragma("unroll") for (int _i = 0; _i < 2; ++_i) \
        __builtin_amdgcn_global_load_lds((const unsigned*)((const char*)(gbase) + (voff)[_i]), (LAS unsigned*)(lds + (bufoff) + ldsw + _i * 8192), 16, 0, 0); } while (0)
#define PG8_LDA(dst, b, h) do { _Pragma("unroll") for (int m = 0; m < 4; ++m) _Pragma("unroll") for (int k = 0; k < 2; ++k) dst[m][k] = *(const LAS bf16x8*)(lds + PG8_SA(b, h) + aoff + m * 2048 + k * 1024); } while (0)
#define PG8_LDB(dst, b, h) do { _Pragma("unroll") for (int n = 0; n < 2; ++n) _Pragma("unroll") for (int k = 0; k < 2; ++k) dst[n][k] = *(const LAS bf16x8*)(lds + PG8_SB(b, h) + boff + n * 2048 + k * 1024); } while (0)
#define PG8_MMA(ai, bj, At, Bt) do { __builtin_amdgcn_s_setprio(1); _Pragma("unroll") for (int m = 0; m < 4; ++m) _Pragma("unroll") for (int n = 0; n < 2; ++n) _Pragma("unroll") for (int k = 0; k < 2; ++k) \
        acc[ai][bj][m][n] = __builtin_amdgcn_mfma_f32_16x16x32_bf16(Bt[n][k], At[m][k], acc[ai][bj][m][n], 0, 0, 0); __builtin_amdgcn_s_setprio(0); } while (0)
#define PG8_WAIT_V(n) asm volatile("s_waitcnt vmcnt(" #n ")" ::: "memory")
#define PG8_WAIT_L(n) asm volatile("s_waitcnt lgkmcnt(" #n ")" ::: "memory")
#define PG8_BAR __builtin_amdgcn_s_barrier()
#define PG8_SCHED __builtin_amdgcn_sched_barrier(0)
    Unit cur, nxt; int ui = 0;
    if (!S.next(0, cur)) return;
    f32x4 acc[2][2][4][2];
#pragma unroll
    for (int a = 0; a < 2; ++a)
#pragma unroll
        for (int b = 0; b < 2; ++b)
#pragma unroll
            for (int m = 0; m < 4; ++m)
#pragma unroll
                for (int n = 0; n < 2; ++n) acc[a][b][m][n] = (f32x4){0.f, 0.f, 0.f, 0.f};
    bf16x8 At[4][2], B0[2][2], B1[2][2];
    const char* cA = (const char*)g.A + (size_t)cur.pm * tstepA + (size_t)cur.kt0 * kstep; const char* cB = (const char*)g.Bt + (size_t)cur.pn * tstepB + (size_t)cur.kt0 * kstep;
    PG8_STAGE(PG8_SB(0, 0), cB, voffB); PG8_STAGE(PG8_SA(0, 0), cA, voffA); PG8_STAGE(PG8_SB(0, 1), cB + hstepB, voffB); PG8_STAGE(PG8_SA(0, 1), cA + hstepA, voffA);
    if (wr == 1) PG8_BAR;
    PG8_WAIT_V(4); PG8_BAR;
    PG8_STAGE(PG8_SB(1, 0), cB + kstep, voffB); PG8_STAGE(PG8_SA(1, 0), cA + kstep, voffA); PG8_STAGE(PG8_SB(1, 1), cB + hstepB + kstep, voffB);
    PG8_WAIT_V(6); PG8_BAR;
    for (;;) {
        const bool has_next = S.next(ui + 1, nxt);
        const char* nA = has_next ? (const char*)g.A + (size_t)nxt.pm * tstepA + (size_t)nxt.kt0 * kstep : cA; const char* nB = has_next ? (const char*)g.Bt + (size_t)nxt.pn * tstepB + (size_t)nxt.kt0 * kstep : cB;
        const int nt = cur.ntu; const bool full = !cur.half;
        for (int t = 0; t < nt; t += 2) {
            const bool last = (t == nt - 2);
            const char* a1 = cA + (size_t)(t + 1) * kstep;
            const char* a2 = last ? nA : cA + (size_t)(t + 2) * kstep; const char* b2 = last ? nB : cB + (size_t)(t + 2) * kstep;
            const char* a3 = a2 + kstep; const char* b3 = b2 + kstep;
            PG8_LDB(B0, 0, 0); PG8_SCHED; PG8_LDA(At, 0, 0); PG8_STAGE(PG8_SA(1, 1), a1 + hstepA, voffA);
            PG8_WAIT_L(8); PG8_BAR; PG8_WAIT_L(0); PG8_MMA(0, 0, At, B0); PG8_BAR; PG8_SCHED;
            PG8_LDB(B1, 0, 1); PG8_STAGE(PG8_SB(0, 0), b2, voffB);
            PG8_BAR; PG8_WAIT_L(0); PG8_MMA(0, 1, At, B1); PG8_BAR;
            PG8_LDA(At, 0, 1); PG8_STAGE(PG8_SA(0, 0), a2, voffA);
            PG8_BAR; PG8_WAIT_L(0); if (full) PG8_MMA(1, 0, At, B0); PG8_BAR; PG8_SCHED;
            PG8_STAGE(PG8_SB(0, 1), b2 + hstepB, voffB);
            PG8_WAIT_V(6); PG8_BAR; if (full) PG8_MMA(1, 1, At, B1); PG8_BAR;
            PG8_LDB(B0, 1, 0); PG8_SCHED; PG8_LDA(At, 1, 0); PG8_STAGE(PG8_SA(0, 1), a2 + hstepA, voffA);
            PG8_WAIT_L(8); PG8_BAR; PG8_WAIT_L(0); PG8_MMA(0, 0, At, B0); PG8_BAR; PG8_SCHED;
            PG8_LDB(B1, 1, 1); PG8_STAGE(PG8_SB(1, 0), b3, voffB);
            PG8_BAR; PG8_WAIT_L(0); PG8_MMA(0, 1, At, B1); PG8_BAR;
            PG8_LDA(At, 1, 1); PG8_STAGE(PG8_SA(1, 0), a3, voffA);
            PG8_BAR; PG8_WAIT_L(0); if (full) PG8_MMA(1, 0, At, B0); PG8_BAR; PG8_SCHED;
            PG8_STAGE(PG8_SB(1, 1), b3 + hstepB, voffB);
            PG8_WAIT_V(6); PG8_BAR; if (full) PG8_MMA(1, 1, At, B1); PG8_BAR;
        }
        E(acc, cur, wr, wc, fr, fq);
        if (!has_next) break;
#pragma unroll
        for (int a = 0; a < 2; ++a)
#pragma unroll
            for (int b = 0; b < 2; ++b)
#pragma unroll
                for (int m = 0; m < 4; ++m)
#pragma unroll
                    for (int n = 0; n < 2; ++n) acc[a][b][m][n] = (f32x4){0.f, 0.f, 0.f, 0.f};
        cur = nxt; cA = nA; cB = nB; ++ui;
    }
    PG8_WAIT_V(0);
    if (wr == 0) PG8_BAR;
    PG8_BAR;
#undef PG8_SA
#undef PG8_SB
#undef PG8_STAGE
#undef PG8_LDA
#undef PG8_LDB
#undef PG8_MMA
#undef PG8_WAIT_V
#undef PG8_WAIT_L
#undef PG8_BAR
#undef PG8_SCHED
}
}
using pg8::Unit;

struct EpiSwiglu {
    static constexpr bool PERM = true; bf16_t* O;
    DI void operator()(const f32x4 (&acc)[2][2][4][2], const Unit& u, int wr, int wc, int fr, int fq) const {
        const int row0 = u.pm * 256 + wr * 64 + fr, col0 = u.pn * 128 + wc * 32 + 8 * fq;
#pragma unroll
        for (int ai = 0; ai < 2; ++ai) if (ai == 0 || !u.half)
#pragma unroll
            for (int m = 0; m < 4; ++m) { bf16_t* rowp = O + (size_t)(row0 + ai * 128 + m * 16) * FF + col0;
                const f32x4 g0 = acc[ai][0][m][0], g1 = acc[ai][0][m][1], u0 = acc[ai][1][m][0], u1 = acc[ai][1][m][1];
                u32x4 w; w.x = pk2(silu_f(g0[0]) * u0[0], silu_f(g0[1]) * u0[1]); w.y = pk2(silu_f(g0[2]) * u0[2], silu_f(g0[3]) * u0[3]);
                w.z = pk2(silu_f(g1[0]) * u1[0], silu_f(g1[1]) * u1[1]); w.w = pk2(silu_f(g1[2]) * u1[2], silu_f(g1[3]) * u1[3]);
                *(u32x4*)rowp = w; }
    }
};
struct EpiProj {
    static constexpr bool PERM = true; bf16_t* O; float* dtraw;
    DI void operator()(const f32x4 (&acc)[2][2][4][2], const Unit& u, int wr, int wc, int fr, int fq) const {
        const int row0 = u.pm * 256 + wr * 64 + fr, col0 = u.pn * 256 + wc * 32 + 8 * fq;
#pragma unroll
        for (int ai = 0; ai < 2; ++ai) if (ai == 0 || !u.half)
#pragma unroll
            for (int m = 0; m < 4; ++m) { const int row = row0 + ai * 128 + m * 16; bf16_t* rowp = O + (size_t)row * NINP + col0;
#pragma unroll
                for (int bj = 0; bj < 2; ++bj) { const f32x4 v0 = acc[ai][bj][m][0], v1 = acc[ai][bj][m][1];
                    u32x4 w; w.x = pk2(v0[0], v0[1]); w.y = pk2(v0[2], v0[3]); w.z = pk2(v1[0], v1[1]); w.w = pk2(v1[2], v1[3]);
                    *(u32x4*)(rowp + bj * 128) = w;
                    if (bj == 0 && u.pn == 34 && wc == 0 && fq < 3) { float* dp = dtraw + (size_t)row * 32 + 8 * fq; *(f32x4*)dp = v0; *(f32x4*)(dp + 4) = v1; } } }
    }
};
struct EpiF32 {
    static constexpr bool PERM = false; float* C;
    DI void operator()(const f32x4 (&acc)[2][2][4][2], const Unit& u, int wr, int wc, int fr, int fq) const {
        const int row0 = u.pm * 256 + wr * 64 + fr, col0 = u.pn * 256 + wc * 32 + 4 * fq;
        if (u.split) {
#pragma unroll
            for (int m = 0; m < 4; ++m) { float* rowp = C + (size_t)(row0 + m * 16) * D + col0;
#pragma unroll
                for (int bj = 0; bj < 2; ++bj)
#pragma unroll
                    for (int n = 0; n < 2; ++n)
#pragma unroll
                        for (int e = 0; e < 4; ++e) unsafeAtomicAdd(rowp + bj * 128 + n * 16 + e, acc[0][bj][m][n][e]); }
            return; }
#pragma unroll
        for (int ai = 0; ai < 2; ++ai) if (ai == 0 || !u.half)
#pragma unroll
            for (int m = 0; m < 4; ++m) { float* rowp = C + (size_t)(row0 + ai * 128 + m * 16) * D + col0;
#pragma unroll
                for (int bj = 0; bj < 2; ++bj)
#pragma unroll
                    for (int n = 0; n < 2; ++n) *(f32x4*)(rowp + bj * 128 + n * 16) = acc[ai][bj][m][n]; }
    }
};
template <int SECOND> struct EpiGate {
    static constexpr bool PERM = false; const bf16_t* proj; float* m1; bf16_t* merged;
    DI void operator()(const f32x4 (&acc)[2][2][4][2], const Unit& u, int wr, int wc, int fr, int fq) const {
        const int row0 = u.pm * 256 + wr * 64 + fr, col0 = u.pn * 256 + wc * 32 + 4 * fq;
#pragma unroll
        for (int ai = 0; ai < 2; ++ai) if (ai == 0 || !u.half)
#pragma unroll
            for (int m = 0; m < 4; ++m) { const size_t row = (size_t)(row0 + ai * 128 + m * 16);
#pragma unroll
                for (int bj = 0; bj < 2; ++bj)
#pragma unroll
                    for (int n = 0; n < 2; ++n) { const int c = col0 + bj * 128 + n * 16; const f32x4 a = acc[ai][bj][m][n];
                        const u32x2 gv = *(const u32x2*)(proj + row * NINP + OFF_GATE + SECOND * 1024 + c);
                        f32x4 r; r[0] = sigmoid_f(bflo(gv.x)) * a[0]; r[1] = sigmoid_f(bfhi(gv.x)) * a[1]; r[2] = sigmoid_f(bflo(gv.y)) * a[2]; r[3] = sigmoid_f(bfhi(gv.y)) * a[3];
                        if (SECOND == 0) *(f32x4*)(m1 + row * D + c) = r;
                        else { const f32x4 p = *(const f32x4*)(m1 + row * D + c); u32x2 o; o.x = pk2(p[0] + r[0], p[1] + r[1]); o.y = pk2(p[2] + r[2], p[3] + r[3]); *(u32x2*)(merged + row * D + c) = o; } } }
    }
};

#define XB_TMO      128
#define XB_XCNT(j)  (256  + 64 * (j))
#define XB_XSUB(j)  (1280 + 64 * (j))
#define XB_XGEN(j)  (2304 + 64 * (j))
#define XB_TOP      3328
#define XB_TOPGEN   3392
#define XCD_BAR_WORDS 3456
#define XB_SPIN_CAP (1u << 18)
DI unsigned xb_ld(unsigned* p)              { return __hip_atomic_load(p, __ATOMIC_RELAXED, __HIP_MEMORY_SCOPE_AGENT); }
DI unsigned xb_add(unsigned* p, unsigned v) { return __hip_atomic_fetch_add(p, v, __ATOMIC_RELAXED, __HIP_MEMORY_SCOPE_AGENT); }
DI unsigned xb_xcc_id() { return (unsigned)__builtin_amdgcn_s_getreg((3 << 11) | 20) & 0xFu; }
#define XB_SPIN(cond, bar) do { unsigned _sp = 0; while (cond) { __builtin_amdgcn_s_sleep(1); \
    if ((++_sp & 255u) == 0u) { if (xb_ld(&(bar)[XB_TMO])) break; if (_sp > XB_SPIN_CAP) { atomicAdd(&(bar)[XB_TMO], 1u); break; } } } } while (0)
struct XcdBarrier { unsigned* bar; unsigned x; volatile LAS unsigned* st; };
DI XcdBarrier xcd_barrier_post(unsigned* bar, volatile LAS unsigned* st) {
    XcdBarrier b; b.bar = bar; b.x = xb_xcc_id(); b.st = st;
    if (threadIdx.x == 0) (void)xb_add(&bar[XB_XCNT(b.x)], 1u);
    return b;
}
DI void xcd_barrier_complete(unsigned* bar, unsigned x, unsigned& nloc, unsigned& nx) {
    const unsigned G = gridDim.x * gridDim.y * gridDim.z;
    unsigned sum, cnt, mine, sp = 0u;
    for (;;) {
        sum = 0u; cnt = 0u; mine = 0u;
#pragma unroll
        for (unsigned j = 0; j < 16; ++j) { const unsigned c = xb_ld(&bar[XB_XCNT(j)]); sum += c; cnt += (c > 0u) ? 1u : 0u; mine = (j == x) ? c : mine; }
        if (sum == G) break;
        __builtin_amdgcn_s_sleep(1);
        if ((++sp & 255u) == 0u) { if (xb_ld(&bar[XB_TMO])) break; if (sp > XB_SPIN_CAP) { atomicAdd(&bar[XB_TMO], 1u); break; } }
    }
    nloc = mine > 0u ? mine : 1u; nx = cnt > 0u ? cnt : 1u;
}
DI void xcd_barrier(const XcdBarrier& b) {
    asm volatile("s_waitcnt vmcnt(0)" ::: "memory");
    __syncthreads();
    if (threadIdx.x == 0) {
        unsigned* bar = b.bar;
        __builtin_amdgcn_s_waitcnt(0);
        unsigned nloc = b.st[0], nx = b.st[1];
        if (nloc == 0u) { xcd_barrier_complete(bar, b.x, nloc, nx); b.st[0] = nloc; b.st[1] = nx; }
        const unsigned old = xb_add(&bar[XB_XSUB(b.x)], 1u);
        const unsigned gen = old / nloc;
        if (old + 1u == (gen + 1u) * nloc) {
            __builtin_amdgcn_fence(__ATOMIC_RELEASE, "agent");
            asm volatile("s_waitcnt vmcnt(0)" ::: "memory");
            const unsigned og = xb_add(&bar[XB_TOP], 1u);
            const unsigned tg = og / nx;
            if (og + 1u == (tg + 1u) * nx) xb_add(&bar[XB_TOPGEN], 1u);
            else XB_SPIN(xb_ld(&bar[XB_TOPGEN]) == tg, bar);
            __builtin_amdgcn_fence(__ATOMIC_ACQUIRE, "agent");
            xb_add(&bar[XB_XGEN(b.x)], 1u);
            asm volatile("s_waitcnt vmcnt(0)" ::: "memory");
        } else {
            XB_SPIN(xb_ld(&bar[XB_XGEN(b.x)]) == gen, bar);
            __builtin_amdgcn_fence(__ATOMIC_ACQUIRE, "agent");
            asm volatile("s_waitcnt vmcnt(0)" ::: "memory");
        }
    }
    __syncthreads();
}

struct Frame {
    float* out; unsigned char* ws; unsigned char* lds; int tid, lane, w, nblk, blk;
};
#define F_wgu1 ((bf16_t*)(F.ws + WS_WGU1))
#define F_wd1 ((bf16_t*)(F.ws + WS_WD1))
#define F_wgu2 ((bf16_t*)(F.ws + WS_WGU2))
#define F_wd2 ((bf16_t*)(F.ws + WS_WD2))
#define F_win ((bf16_t*)(F.ws + WS_WIN))
#define F_wa ((bf16_t*)(F.ws + WS_WA))
#define F_wb ((bf16_t*)(F.ws + WS_WB))
#define F_wo ((bf16_t*)(F.ws + WS_WO))
#define F_xn ((bf16_t*)(F.ws + WS_XN))
#define F_proj ((bf16_t*)(F.ws + WS_PROJ))
#define F_xbcc ((bf16_t*)(F.ws + WS_XBCC))
#define F_act ((bf16_t*)(F.ws + WS_ACT))
#define F_dtraw ((float*)(F.ws + WS_DTRAW))
#define F_newkv ((float*)(F.ws + WS_NEWKV))
#define F_cdec ((float*)(F.ws + WS_CDEC))
#define F_f ((float*)(F.ws + WS_F))
#define F_h (F.out)
#define F_sc ((unsigned char*)(F.out + O_KV2048S))
#define F_atto ((bf16_t*)(F_sc + SC_ATTO))
#define F_lse ((float*)(F_sc + SC_LSE))
#define F_states ((bf16_t*)(F_sc + SC_STATES))
#define F_m1 ((float*)(F_sc + SC_M1))

template <class Epi> DI void run_gemm(const Frame& F, const bf16_t* A, int lda, const bf16_t* Bt, int N, int K, const Epi& E, int split_sl = 0) {
    pg8::Gemm g; g.A = A; g.Bt = Bt; g.M = MT; g.N = N; g.K = K; g.lda = lda;
    pg8::StaticOrder S; S.init(MT, N, K, F.nblk, F.blk, split_sl);
    pg8::gemm_phase<Epi>((LAS unsigned char*)F.lds, g, S, E);
}

DI void zero_f_sample(const Frame& F) {
    f32x4* p = (f32x4*)(F_f + (size_t)MP * D);
    for (int i = F.blk * 512 + F.tid; i < 128 * 256; i += F.nblk * 512) p[i] = (f32x4){0.f, 0.f, 0.f, 0.f};
}
DI void transpose_item(const float* __restrict__ W, int K, int N, int NP, bf16_t* __restrict__ WT, float* scr, int item, int lane, int kind) {
    const int nblk = NP / 32, kb = item / nblk, nb = item % nblk, k0 = 64 * kb, n0 = 32 * nb;
    const int nn = n0 + (lane & 31);
#pragma unroll 8
    for (int i = 0; i < 32; ++i) { const int kk = 2 * i + (lane >> 5); scr[kk * 33 + (lane & 31)] = nn < N ? W[(size_t)(k0 + kk) * N + nn] : 0.f; }
    asm volatile("s_waitcnt lgkmcnt(0)" ::: "memory");
    const int c = lane & 7;
#pragma unroll
    for (int j = 0; j < 4; ++j) { const int n = (lane >> 3) + 8 * j; const float* s = scr + (8 * c) * 33 + n;
        u32x4 o; o.x = pk2(s[0 * 33], s[1 * 33]); o.y = pk2(s[2 * 33], s[3 * 33]); o.z = pk2(s[4 * 33], s[5 * 33]); o.w = pk2(s[6 * 33], s[7 * 33]);
        const int ng = n0 + n; const int row = kind == 0 ? ng : ((ng >> 7) * 256 + (ng & 127) + (kind == 2 ? 128 : 0));
        *(u32x4*)(WT + (size_t)row * K + k0 + 8 * c) = o; }
    asm volatile("s_waitcnt lgkmcnt(0)" ::: "memory");
}
DI void ld_row(const float* p, int lane, f32x4 (&v)[4]) { const f32x4* q = (const f32x4*)p + lane;
#pragma unroll
    for (int j = 0; j < 4; ++j) v[j] = q[64 * j]; }
DI float row_sumsq(const f32x4 (&v)[4]) { float s = 0.f;
#pragma unroll
    for (int j = 0; j < 4; ++j) s += (v[j][0] * v[j][0] + v[j][1] * v[j][1]) + (v[j][2] * v[j][2] + v[j][3] * v[j][3]);
    return wave_sum(s); }
DI void st_row_bf16(bf16_t* o, int lane, const f32x4 (&v)[4]) { u32x2* q = (u32x2*)o + lane;
#pragma unroll
    for (int j = 0; j < 4; ++j) { u32x2 t; t.x = pk2(v[j][0], v[j][1]); t.y = pk2(v[j][2], v[j][3]); q[64 * j] = t; } }
DI void st_row_f32(float* o, int lane, const f32x4 (&v)[4]) { f32x4* q = (f32x4*)o + lane;
#pragma unroll
    for (int j = 0; j < 4; ++j) q[64 * j] = v[j]; }

DI void phase_prep(const Params& P, const Frame& F) {
    float* scr = (float*)F.lds + F.w * (64 * 33 + 32);
    const int gw = F.blk * 8 + F.w, NGW = F.nblk * 8;
    constexpr int I_FU = 16 * 88, I_FD = 44 * 32, I_IN = 16 * (NINP / 32), I_A = 8 * 32, I_B = 24 * 32, I_O = 16 * 32;
    constexpr int NITEMS = 4 * I_FU + 2 * I_FD + I_IN + I_A + I_B + I_O;
    for (int it = gw; it < NITEMS; it += NGW) {
        int r = it;
        if (r < I_FU) { transpose_item(P.in[I_G1], 1024, FF, FF, F_wgu1, scr, r, F.lane, 1); continue; } r -= I_FU;
        if (r < I_FU) { transpose_item(P.in[I_U1], 1024, FF, FF, F_wgu1, scr, r, F.lane, 2); continue; } r -= I_FU;
        if (r < I_FU) { transpose_item(P.in[I_G2], 1024, FF, FF, F_wgu2, scr, r, F.lane, 1); continue; } r -= I_FU;
        if (r < I_FU) { transpose_item(P.in[I_U2], 1024, FF, FF, F_wgu2, scr, r, F.lane, 2); continue; } r -= I_FU;
        if (r < I_FD) { transpose_item(P.in[I_D1], FF, 1024, 1024, F_wd1, scr, r, F.lane, 0); continue; } r -= I_FD;
        if (r < I_FD) { transpose_item(P.in[I_D2], FF, 1024, 1024, F_wd2, scr, r, F.lane, 0); continue; } r -= I_FD;
        if (r < I_IN) { transpose_item(P.in[I_WIN], 1024, NIN, NINP, F_win, scr, r, F.lane, 0); continue; } r -= I_IN;
        if (r < I_A) { transpose_item(P.in[I_WA], 512, 1024, 1024, F_wa, scr, r, F.lane, 0); continue; } r -= I_A;
        if (r < I_B) { transpose_item(P.in[I_WB], 1536, 1024, 1024, F_wb, scr, r, F.lane, 0); continue; } r -= I_B;
        transpose_item(P.in[I_WO], 1024, 1024, 1024, F_wo, scr, r, F.lane, 0);
    }
    f32x4 g[4]; ld_row(P.in[I_GPRE1], F.lane, g);
    for (int row = gw; row < MT; row += NGW) {
        f32x4 v[4];
        if (row < MROWS) { const float* src = row < MP ? P.in[I_XP] + (size_t)row * D : P.in[I_XS] + (size_t)(row - MP) * D; ld_row(src, F.lane, v);
            const float rn = rsqrtf(row_sumsq(v) * (1.f / D) + EPS);
#pragma unroll
            for (int j = 0; j < 4; ++j) v[j] = v[j] * rn * g[j];
        } else {
#pragma unroll
            for (int j = 0; j < 4; ++j) v[j] = (f32x4){0.f, 0.f, 0.f, 0.f}; }
        st_row_bf16(F_xn + (size_t)row * D, F.lane, v);
    }
}

template <int MODE> DI void phase_rows(const Params& P, const Frame& F) {
    const int gw = F.blk * 8 + F.w, NGW = F.nblk * 8;
    f32x4 gp[4], gn[4];
    ld_row(P.in[MODE == 0 ? I_GPOST1 : (MODE == 1 ? I_GPOSTM : I_GPOST2)], F.lane, gp);
    if (MODE < 2) ld_row(P.in[MODE == 0 ? I_GPREM : I_GPRE2], F.lane, gn);
    const float sc = MODE == 1 ? 1.f : 0.5f;
    f32x4 f[4], x[4], fn[4], xq[4];
    auto load_row = [&](int row, f32x4 (&ff)[4], f32x4 (&xx)[4]) {
        ld_row(F_f + (size_t)row * D, F.lane, ff);
        if (MODE == 0) ld_row(row < MP ? P.in[I_XP] + (size_t)row * D : P.in[I_XS] + (size_t)(row - MP) * D, F.lane, xx);
        else ld_row(F_h + (size_t)row * D, F.lane, xx); };
    if (gw < MROWS) load_row(gw, f, x);
    for (int row = gw; row < MROWS; row += NGW) {
        const int nrow = row + NGW;
        if (nrow < MROWS) load_row(nrow, fn, xq);
        const float rn = rsqrtf(row_sumsq(f) * (1.f / D) + EPS) * sc;
#pragma unroll
        for (int j = 0; j < 4; ++j) x[j] = x[j] + f[j] * rn * gp[j];
        st_row_f32(F_h + (size_t)row * D, F.lane, x);
        if (MODE < 2) {
            const float r2 = rsqrtf(row_sumsq(x) * (1.f / D) + EPS);
#pragma unroll
            for (int j = 0; j < 4; ++j) x[j] = x[j] * r2 * gn[j];
            st_row_bf16(F_xn + (size_t)row * D, F.lane, x);
        }
#pragma unroll
        for (int j = 0; j < 4; ++j) { f[j] = fn[j]; x[j] = xq[j]; }
    }
}

struct AttnRegs { u32x4 kv[4], vv[4]; bf16x8 qf[2]; };
DI void attn_decode(int unit, int& b, int& g, int& h, int& dil, int& r, int& n) {
    const int blk = unit & 63; h = (unit >> 6) & 7; const int bg = unit >> 9; g = bg % 3; b = bg / 3;
    dil = g == 0 ? 1 : (g == 1 ? 4 : 16); const int nb = 64 / dil; r = blk / nb; n = blk % nb;
}
DI void attn_fetch(const Frame& F, int unit, AttnRegs& R) {
    int b, g, h, dil, r, n; attn_decode(unit, b, g, h, dil, r, n);
    const bf16_t* proj = F_proj + (size_t)b * SEQ * NINP;
    const int qc = g * 1536 + h * 64, kc = qc + 512, vc = qc + 1024;
#pragma unroll
    for (int i = 0; i < 4; ++i) {
        const int idx = F.tid + 512 * i, key = idx >> 3, ch = idx & 7;
        const int ck = (n - 1) * 128 + key;
        R.kv[i] = (u32x4){0u, 0u, 0u, 0u}; R.vv[i] = (u32x4){0u, 0u, 0u, 0u};
        if (ck >= 0) { const bf16_t* rowp = proj + ((size_t)ck * dil + r) * NINP; R.kv[i] = *(const u32x4*)(rowp + kc + ch * 8); R.vv[i] = *(const u32x4*)(rowp + vc + ch * 8); }
    }
    const int qi = (F.tid >> 6) * 16 + (F.lane & 15), quad = F.lane >> 4;
    const size_t qtok = (size_t)(n * 128 + qi) * dil + r;
#pragma unroll
    for (int ks = 0; ks < 2; ++ks) R.qf[ks] = *(const bf16x8*)(proj + qtok * NINP + qc + ks * 32 + quad * 8);
}
DI void phase_attn(const Frame& F, int nrep) {
    const int tid = F.tid;
    bf16_t* Ks = (bf16_t*)F.lds;
    bf16_t* Vt = Ks + 256 * 72;
    const int total = 6144 * nrep;
    AttnRegs R;
    if (F.blk < total) attn_fetch(F, F.blk % 6144, R);
    for (int uu = F.blk; uu < total; uu += F.nblk) {
        const int unit = uu % 6144;
        int b, g, h, dil, r, n; attn_decode(unit, b, g, h, dil, r, n);
#pragma unroll
        for (int i = 0; i < 4; ++i) {
            const int idx = tid + 512 * i, key = idx >> 3, ch = idx & 7;
            *(u32x4*)(Ks + key * 72 + ch * 8) = R.kv[i];
            const u32x4 vv = R.vv[i];
            bf16_t* vd = Vt + (ch * 8) * 264 + key;
            vd[0 * 264] = (bf16_t)(vv.x & 0xffffu); vd[1 * 264] = (bf16_t)(vv.x >> 16); vd[2 * 264] = (bf16_t)(vv.y & 0xffffu); vd[3 * 264] = (bf16_t)(vv.y >> 16);
            vd[4 * 264] = (bf16_t)(vv.z & 0xffffu); vd[5 * 264] = (bf16_t)(vv.z >> 16); vd[6 * 264] = (bf16_t)(vv.w & 0xffffu); vd[7 * 264] = (bf16_t)(vv.w >> 16);
        }
        const bf16x8 qf0 = R.qf[0], qf1 = R.qf[1];
        lds_barrier();
        if (uu + F.nblk < total) attn_fetch(F, (uu + F.nblk) % 6144, R);
        const int w = tid >> 6, lane = F.lane, l15 = lane & 15, quad = lane >> 4;
        const int qi = w * 16 + l15;
        const size_t qtok = (size_t)(n * 128 + qi) * dil + r;
        const int kt0 = w & ~1;
        f32x4 s[10];
#pragma unroll
        for (int t = 0; t < 10; ++t) { s[t] = (f32x4){0.f, 0.f, 0.f, 0.f};
            const bf16x8 kf0 = *(const bf16x8*)(Ks + ((kt0 + t) * 16 + l15) * 72 + quad * 8), kf1 = *(const bf16x8*)(Ks + ((kt0 + t) * 16 + l15) * 72 + 32 + quad * 8);
            s[t] = mfma16(kf0, qf0, s[t]); s[t] = mfma16(kf1, qf1, s[t]); }
        float m = -INFINITY;
#pragma unroll
        for (int t = 0; t < 10; ++t)
#pragma unroll
            for (int jj = 0; jj < 4; ++jj) { const int kj = (kt0 + t) * 16 + quad * 4 + jj; const bool valid = (kj >= qi) && (kj <= qi + 128) && (n > 0 || kj >= 128);
                const float v = valid ? s[t][jj] : -INFINITY; s[t][jj] = v; m = fmaxf(m, v); }
        m = fmaxf(m, __shfl_xor(m, 16)); m = fmaxf(m, __shfl_xor(m, 32));
        const float sc = 0.125f * 1.4426950408889634f;
        float den = 0.f;
#pragma unroll
        for (int t = 0; t < 10; ++t)
#pragma unroll
            for (int jj = 0; jj < 4; ++jj) { const float p = __builtin_amdgcn_exp2f((s[t][jj] - m) * sc); s[t][jj] = p; den += p; }
        den += __shfl_xor(den, 16); den += __shfl_xor(den, 32);
        f32x4 o[4];
#pragma unroll
        for (int et = 0; et < 4; ++et) o[et] = (f32x4){0.f, 0.f, 0.f, 0.f};
#pragma unroll
        for (int sg = 0; sg < 5; ++sg) {
            u32x4 pw; pw.x = pk2(s[2 * sg][0], s[2 * sg][1]); pw.y = pk2(s[2 * sg][2], s[2 * sg][3]); pw.z = pk2(s[2 * sg + 1][0], s[2 * sg + 1][1]); pw.w = pk2(s[2 * sg + 1][2], s[2 * sg + 1][3]);
            const bf16x8 pf = __builtin_bit_cast(bf16x8, pw);
            const int kb = (kt0 + 2 * sg) * 16;
#pragma unroll
            for (int et = 0; et < 4; ++et) { const bf16_t* vr = Vt + (et * 16 + l15) * 264 + kb + quad * 4;
                const s16x4 lo = *(const s16x4*)vr, hi = *(const s16x4*)(vr + 16);
                const bf16x8 vf = __builtin_shufflevector(lo, hi, 0, 1, 2, 3, 4, 5, 6, 7);
                o[et] = mfma16(vf, pf, o[et]); }
        }
        const float inv = 1.f / den;
        const size_t grow = (size_t)b * SEQ + qtok;
        bf16_t* op = F_atto + grow * 1536 + g * 512 + h * 64 + quad * 4;
#pragma unroll
        for (int et = 0; et < 4; ++et) { u32x2 t; t.x = pk2(o[et][0] * inv, o[et][1] * inv); t.y = pk2(o[et][2] * inv, o[et][3] * inv); *(u32x2*)(op + et * 16) = t; }
        if (quad == 0) F_lse[grow * 24 + g * 8 + h] = m * 0.125f + __logf(den);
        lds_barrier();
    }
}

template <int NCOLS>
DI void conv_stage(const bf16_t* __restrict__ src, bool has_prev, const float* __restrict__ cw, const float* __restrict__ cb, bf16_t* dst, int ld, const float* dt_h, const float* cs_h, bf16_t* __restrict__ gdst, int tid) {
    constexpr int nch = NCOLS / 8, nseg = 512 / nch, rps = 128 / nseg;
    const int ch = tid % nch, seg = tid / nch, j0 = seg * rps;
    float wt[4][8], bias[8], xm[3][8];
#pragma unroll
    for (int t = 0; t < 4; ++t) { const f32x4 a = *(const f32x4*)(cw + t * 2560 + ch * 8), c = *(const f32x4*)(cw + t * 2560 + ch * 8 + 4);
        wt[t][0] = a[0]; wt[t][1] = a[1]; wt[t][2] = a[2]; wt[t][3] = a[3]; wt[t][4] = c[0]; wt[t][5] = c[1]; wt[t][6] = c[2]; wt[t][7] = c[3]; }
    { const f32x4 a = *(const f32x4*)(cb + ch * 8), c = *(const f32x4*)(cb + ch * 8 + 4);
        bias[0] = a[0]; bias[1] = a[1]; bias[2] = a[2]; bias[3] = a[3]; bias[4] = c[0]; bias[5] = c[1]; bias[6] = c[2]; bias[7] = c[3]; }
#pragma unroll
    for (int k = 0; k < 3; ++k) { const int j = j0 - 3 + k;
        if (j >= 0 || has_prev) { const u32x4 v = *(const u32x4*)(src + (ptrdiff_t)j * NINP + ch * 8); unpack8(v, xm[k]); }
        else {
#pragma unroll
            for (int e = 0; e < 8; ++e) xm[k][e] = 0.f; } }
    const float cl = dt_h ? cs_h[127] : 0.f;
#pragma unroll
    for (int r = 0; r < rps; ++r) { const int j = j0 + r; float x0[8], y[8];
        { const u32x4 v = *(const u32x4*)(src + (ptrdiff_t)j * NINP + ch * 8); unpack8(v, x0); }
#pragma unroll
        for (int e = 0; e < 8; ++e) { const float t = bias[e] + wt[0][e] * xm[0][e] + wt[1][e] * xm[1][e] + wt[2][e] * xm[2][e] + wt[3][e] * x0[e]; y[e] = silu_f(t); }
        { u32x4 o; o.x = pk2(y[0], y[1]); o.y = pk2(y[2], y[3]); o.z = pk2(y[4], y[5]); o.w = pk2(y[6], y[7]); *(u32x4*)(gdst + (size_t)j * 2560 + ch * 8) = o; }
        if (dst) { const float sc = dt_h ? dt_h[j] * __expf(cl - cs_h[j]) : 1.f;
#pragma unroll
            for (int e = 0; e < 8; ++e) dst[(ch * 8 + e) * ld + j] = f2bf(y[e] * sc); }
#pragma unroll
        for (int e = 0; e < 8; ++e) { xm[0][e] = xm[1][e]; xm[1][e] = xm[2][e]; xm[2][e] = x0[e]; }
    }
}
DI void dtcs_stage(const float* dtraw0, const float* dt_bias6, const float* a_log6, float* dt_s, float* cs_s, int w, int lane) {
    if (w < 6) { const float bias = dt_bias6[w], A = -__expf(a_log6[w]);
        const int j = 2 * lane; const float r0 = dtraw0[(size_t)j * 32 + w], r1 = dtraw0[(size_t)(j + 1) * 32 + w];
        const float d0 = softplus_f(r0 + bias), d1 = softplus_f(r1 + bias), a0 = d0 * A, a1 = d1 * A; float s = a0 + a1;
#pragma unroll
        for (int o = 1; o < 64; o <<= 1) { const float t = __shfl_up(s, o); if (lane >= o) s += t; }
        const float ex = s - (a0 + a1);
        dt_s[w * 128 + j] = d0; dt_s[w * 128 + j + 1] = d1; cs_s[w * 128 + j] = ex + a0; cs_s[w * 128 + j + 1] = ex + a0 + a1; }
}

DI void ssd1_unit(const Params& P, const Frame& F, int unit) {
    const int tid = F.tid, w = F.w, lane = F.lane, l15 = lane & 15, quad = lane >> 4;
    const int g = unit & 3, c = (unit >> 2) & 63, b = unit >> 8;
    const size_t tok0 = (size_t)b * SEQ + c * 128;
    bf16_t* BT = (bf16_t*)F.lds;
    bf16_t* xT = BT + 128 * 136;
    float* dt_s = (float*)(F.lds + 139264);
    float* cs_s = dt_s + 768;
    const bf16_t* src = F_proj + tok0 * NINP + OFF_XBC;
    bf16_t* gx = F_xbcc + tok0 * 2560;
    dtcs_stage(F_dtraw + tok0 * 32 + 6 * g, P.in[I_DTB] + 6 * g, P.in[I_ALOG] + 6 * g, dt_s, cs_s, w, lane);
    conv_stage<128>(src + 1536 + 128 * g, c > 0, P.in[I_CONVW] + 1536 + 128 * g, P.in[I_CONVB] + 1536 + 128 * g, BT, 136, nullptr, nullptr, gx + 1536 + 128 * g, tid);
    conv_stage<128>(src + 2048 + 128 * g, c > 0, P.in[I_CONVW] + 2048 + 128 * g, P.in[I_CONVB] + 2048 + 128 * g, nullptr, 136, nullptr, nullptr, gx + 2048 + 128 * g, tid);
    __syncthreads();
#pragma unroll 1
    for (int hh = 0; hh < 6; ++hh) { const int co = 384 * g + 64 * hh;
        conv_stage<64>(src + co, c > 0, P.in[I_CONVW] + co, P.in[I_CONVB] + co, xT + hh * 64 * 136, 136, dt_s + hh * 128, cs_s + hh * 128, gx + co, tid); }
    __syncthreads();
#pragma unroll 1
    for (int hh = 0; hh < 6; ++hh) {
        const int h = 6 * g + hh;
        f32x4 acc[4];
#pragma unroll
        for (int pt = 0; pt < 4; ++pt) acc[pt] = (f32x4){0.f, 0.f, 0.f, 0.f};
#pragma unroll
        for (int ks = 0; ks < 4; ++ks) { const bf16x8 xb = *(const bf16x8*)(BT + (w * 16 + l15) * 136 + ks * 32 + quad * 8);
#pragma unroll
            for (int pt = 0; pt < 4; ++pt) { const bf16x8 yb = *(const bf16x8*)(xT + (hh * 64 + pt * 16 + l15) * 136 + ks * 32 + quad * 8); acc[pt] = mfma16(xb, yb, acc[pt]); } }
        bf16_t* sp = F_states + ((size_t)(b * 64 + c) * 24 + h) * 8192 + w * 16 + quad * 4;
#pragma unroll
        for (int pt = 0; pt < 4; ++pt) { u32x2 t; t.x = pk2(acc[pt][0], acc[pt][1]); t.y = pk2(acc[pt][2], acc[pt][3]); *(u32x2*)(sp + (pt * 16 + l15) * 128) = t; }
        if (tid == 0) F_cdec[(b * 64 + c) * 24 + h] = __expf(cs_s[hh * 128 + 127]);
    }
    __syncthreads();
}

DI void phase_scan(const Frame& F) {
    const int total = 4 * 24 * 64 * 32, nthreads = F.nblk * 512;
    float* outp = F.out + O_SSMP;
    for (int it = F.blk * 512 + F.tid; it < total; it += nthreads) {
        const int n4 = it & 31, p = (it >> 5) & 63, h = (it >> 11) % 24, b = it / 49152;
        bf16_t* base = F_states + ((size_t)(b * 64) * 24 + h) * 8192 + p * 128 + n4 * 4;
        const float* dcp = F_cdec + (b * 64) * 24 + h;
        f32x4 run = (f32x4){0.f, 0.f, 0.f, 0.f};
        for (int c0 = 0; c0 < 64; c0 += 8) {
            u32x2 sv[8]; float dc[8];
#pragma unroll
            for (int k = 0; k < 8; ++k) { sv[k] = *(const u32x2*)(base + (size_t)(c0 + k) * 24 * 8192); dc[k] = dcp[(c0 + k) * 24]; }
#pragma unroll
            for (int k = 0; k < 8; ++k) { u32x2 pv; pv.x = pk2(run[0], run[1]); pv.y = pk2(run[2], run[3]); *(u32x2*)(base + (size_t)(c0 + k) * 24 * 8192) = pv;
                run[0] = run[0] * dc[k] + bflo(sv[k].x); run[1] = run[1] * dc[k] + bfhi(sv[k].x); run[2] = run[2] * dc[k] + bflo(sv[k].y); run[3] = run[3] * dc[k] + bfhi(sv[k].y); }
        }
        *(f32x4*)(outp + ((size_t)(b * 24 + h) * 64 + p) * 128 + n4 * 4) = run;
    }
}

DI void ssd3_unit(const Params& P, const Frame& F, int unit) {
    const int tid = F.tid, w = F.w, lane = F.lane, l15 = lane & 15, quad = lane >> 4;
    const int g = unit & 3, c = (unit >> 2) & 63, b = unit >> 8;
    const size_t tok0 = (size_t)b * SEQ + c * 128;
    bf16_t* Bs = (bf16_t*)F.lds;
    bf16_t* xT = Bs + 128 * 136;
    float* dt_s = (float*)(F.lds + 139264);
    float* cs_s = dt_s + 768;
    float* nw_s = cs_s + 768;
    const bf16_t* gx = F_xbcc + tok0 * 2560;
    dtcs_stage(F_dtraw + tok0 * 32 + 6 * g, P.in[I_DTB] + 6 * g, P.in[I_ALOG] + 6 * g, dt_s, cs_s, w, lane);
    if (tid < 96) *(f32x4*)(nw_s + tid * 4) = *(const f32x4*)(P.in[I_NORMW] + 384 * g + tid * 4);
#pragma unroll
    for (int k = 0; k < 4; ++k) { const int idx = tid + 512 * k, row = idx >> 4, ch = idx & 15;
        *(u32x4*)(Bs + row * 136 + ch * 8) = *(const u32x4*)(gx + (size_t)row * 2560 + 1536 + 128 * g + ch * 8); }
#pragma unroll 4
    for (int k = 0; k < 12; ++k) { const int idx = tid + 512 * k, ch = (idx & 7) + 8 * (idx / 1024), row = (idx >> 3) & 127;
        const u32x4 v = *(const u32x4*)(gx + (size_t)row * 2560 + 384 * g + ch * 8);
        bf16_t* d = xT + (ch * 8) * 136 + row;
        d[0 * 136] = (bf16_t)(v.x & 0xffffu); d[1 * 136] = (bf16_t)(v.x >> 16); d[2 * 136] = (bf16_t)(v.y & 0xffffu); d[3 * 136] = (bf16_t)(v.y >> 16);
        d[4 * 136] = (bf16_t)(v.z & 0xffffu); d[5 * 136] = (bf16_t)(v.z >> 16); d[6 * 136] = (bf16_t)(v.w & 0xffffu); d[7 * 136] = (bf16_t)(v.w >> 16); }
    const int i = w * 16 + l15;
    bf16x8 Cf[4];
#pragma unroll
    for (int ks = 0; ks < 4; ++ks) Cf[ks] = *(const bf16x8*)(gx + (size_t)i * 2560 + 2048 + 128 * g + ks * 32 + quad * 8);
    __syncthreads();
    f32x4 gt[8];
#pragma unroll
    for (int jt = 0; jt < 8; ++jt) { gt[jt] = (f32x4){0.f, 0.f, 0.f, 0.f};
        if (jt <= w) {
#pragma unroll
            for (int ks = 0; ks < 4; ++ks) { const bf16x8 xb = *(const bf16x8*)(Bs + (jt * 16 + l15) * 136 + ks * 32 + quad * 8); gt[jt] = mfma16(xb, Cf[ks], gt[jt]); } } }
    float ss = 0.f;
    const size_t orow = (tok0 + i) * NINP;
#pragma unroll 1
    for (int hh = 0; hh < 6; ++hh) {
        const int h = 6 * g + hh, h3 = hh;
        const float csi = cs_s[hh * 128 + i];
        u32x2 zv4[4];
#pragma unroll
        for (int pt = 0; pt < 4; ++pt) zv4[pt] = *(const u32x2*)(F_proj + orow + OFF_Z + 384 * g + hh * 64 + pt * 16 + quad * 4);
        f32x4 ya[4], off[4];
#pragma unroll
        for (int pt = 0; pt < 4; ++pt) { ya[pt] = (f32x4){0.f, 0.f, 0.f, 0.f}; off[pt] = (f32x4){0.f, 0.f, 0.f, 0.f}; }
#pragma unroll
        for (int sg = 0; sg < 4; ++sg) {
            if (2 * sg <= w) {
                float pv[8];
#pragma unroll
                for (int q = 0; q < 2; ++q) { const int jt = 2 * sg + q, jb = jt * 16 + quad * 4;
                    const f32x4 csj = *(const f32x4*)(cs_s + hh * 128 + jb), dtj = *(const f32x4*)(dt_s + hh * 128 + jb);
#pragma unroll
                    for (int jj = 0; jj < 4; ++jj) { const int j = jb + jj; const float e = __expf(fminf(csi - csj[jj], 0.f)) * dtj[jj]; pv[q * 4 + jj] = (j <= i) ? gt[jt][jj] * e : 0.f; } }
                u32x4 pw; pw.x = pk2(pv[0], pv[1]); pw.y = pk2(pv[2], pv[3]); pw.z = pk2(pv[4], pv[5]); pw.w = pk2(pv[6], pv[7]);
                const bf16x8 pf = __builtin_bit_cast(bf16x8, pw);
#pragma unroll
                for (int pt = 0; pt < 4; ++pt) { const bf16_t* xr = xT + (h3 * 64 + pt * 16 + l15) * 136 + sg * 32 + quad * 4;
                    const s16x4 lo = *(const s16x4*)xr, hi = *(const s16x4*)(xr + 16);
                    const bf16x8 xf = __builtin_shufflevector(lo, hi, 0, 1, 2, 3, 4, 5, 6, 7);
                    ya[pt] = mfma16(xf, pf, ya[pt]); }
            }
        }
        const bf16_t* pr = F_states + ((size_t)(b * 64 + c) * 24 + h) * 8192;
#pragma unroll
        for (int pt = 0; pt < 4; ++pt)
#pragma unroll
            for (int ks = 0; ks < 4; ++ks) { const bf16x8 xb = *(const bf16x8*)(pr + (pt * 16 + l15) * 128 + ks * 32 + quad * 8); off[pt] = mfma16(xb, Cf[ks], off[pt]); }
        const float ecs = __expf(csi), Dh = P.in[I_DSKIP][h];
#pragma unroll
        for (int pt = 0; pt < 4; ++pt) { const int p0 = pt * 16 + quad * 4;
            const u32x2 zv = zv4[pt];
            const float z[4] = {bflo(zv.x), bfhi(zv.x), bflo(zv.y), bfhi(zv.y)};
            float yv[4];
#pragma unroll
            for (int jj = 0; jj < 4; ++jj) { const float xv = bf2f(xT[(h3 * 64 + p0 + jj) * 136 + i]);
                yv[jj] = (ya[pt][jj] + off[pt][jj] * ecs + Dh * xv) * silu_f(z[jj]); ss += yv[jj] * yv[jj]; }
            u32x2 t; t.x = pk2(yv[0], yv[1]); t.y = pk2(yv[2], yv[3]);
            *(u32x2*)(F_proj + orow + 512 + 384 * g + hh * 64 + p0) = t; }
    }
    ss += __shfl_xor(ss, 16); ss += __shfl_xor(ss, 32);
    const float rn = rsqrtf(ss * (1.f / 384.f) + EPS);
    u32x2 yb[6][4];
#pragma unroll
    for (int hh = 0; hh < 6; ++hh)
#pragma unroll
        for (int pt = 0; pt < 4; ++pt) yb[hh][pt] = *(const u32x2*)(F_proj + orow + 512 + 384 * g + hh * 64 + pt * 16 + quad * 4);
#pragma unroll
    for (int hh = 0; hh < 6; ++hh)
#pragma unroll
        for (int pt = 0; pt < 4; ++pt) { const int cc = hh * 64 + pt * 16 + quad * 4; const f32x4 wv = *(const f32x4*)(nw_s + cc); const u32x2 yv = yb[hh][pt];
            u32x2 t; t.x = pk2(bflo(yv.x) * rn * wv[0], bfhi(yv.x) * rn * wv[1]); t.y = pk2(bflo(yv.y) * rn * wv[2], bfhi(yv.y) * rn * wv[3]);
            *(u32x2*)(F_proj + orow + 512 + 384 * g + cc) = t; }
    __syncthreads();
}

DI void sample_ssd_item(const Params& P, const Frame& F, int item) {
    const int tid = F.tid, w = F.w, lane = F.lane;
    const int b = item >> 2, g = item & 3;
    float* xs = (float*)F.lds;
    float* Bs = xs + 1536;
    float* Cs = Bs + 512;
    float* dts = Cs + 512;
    float* yg = dts + 32;
    const size_t row0 = (size_t)MP + 4 * b;
    for (int idx = tid; idx < 640; idx += 512) {
        const int col = idx < 384 ? 384 * g + idx : (idx < 512 ? 1536 + 128 * g + (idx - 384) : 2048 + 128 * g + (idx - 512));
        float xp[7];
#pragma unroll
        for (int k = 0; k < 3; ++k) xp[k] = P.in[I_SCONV][((size_t)b * 3 + k) * 2560 + col];
#pragma unroll
        for (int l = 0; l < 4; ++l) xp[3 + l] = bf2f(F_proj[(row0 + l) * NINP + OFF_XBC + col]);
        const float w0 = P.in[I_CONVW][col], w1 = P.in[I_CONVW][2560 + col], w2 = P.in[I_CONVW][5120 + col], w3 = P.in[I_CONVW][7680 + col], bs = P.in[I_CONVB][col];
#pragma unroll
        for (int l = 0; l < 4; ++l) { const float y = silu_f(bs + w0 * xp[l] + w1 * xp[l + 1] + w2 * xp[l + 2] + w3 * xp[l + 3]);
            if (idx < 384) xs[l * 384 + idx] = y; else if (idx < 512) Bs[l * 128 + idx - 384] = y; else Cs[l * 128 + idx - 512] = y; }
    }
    if (tid < 24) { const int l = tid / 6, hh = tid % 6; dts[l * 8 + hh] = softplus_f(F_dtraw[(row0 + l) * 32 + 6 * g + hh] + P.in[I_DTB][6 * g + hh]); }
    __syncthreads();
    const int p = tid >> 3, nq = tid & 7;
#pragma unroll 1
    for (int hh = 0; hh < 6; ++hh) {
        const int h = 6 * g + hh; const float A = -__expf(P.in[I_ALOG][h]), Dh = P.in[I_DSKIP][h];
        const size_t so = ((size_t)(b * 24 + h) * 64 + p) * 128 + nq * 16;
        f32x4 s[4];
#pragma unroll
        for (int q = 0; q < 4; ++q) s[q] = *(const f32x4*)(P.in[I_SSSM] + so + 4 * q);
#pragma unroll
        for (int l = 0; l < 4; ++l) { const float dt = dts[l * 8 + hh], dA = __expf(dt * A), xv = xs[l * 384 + hh * 64 + p], dx = dt * xv; float yp = 0.f;
#pragma unroll
            for (int q = 0; q < 4; ++q) { const f32x4 Bv = *(const f32x4*)(Bs + l * 128 + nq * 16 + 4 * q), Cv = *(const f32x4*)(Cs + l * 128 + nq * 16 + 4 * q);
                s[q] = s[q] * dA + Bv * dx; yp += (Cv[0] * s[q][0] + Cv[1] * s[q][1]) + (Cv[2] * s[q][2] + Cv[3] * s[q][3]); }
            yp += __shfl_xor(yp, 1); yp += __shfl_xor(yp, 2); yp += __shfl_xor(yp, 4);
            if (nq == 0) { const float z = bf2f(F_proj[(row0 + l) * NINP + OFF_Z + 384 * g + hh * 64 + p]); yg[l * 384 + hh * 64 + p] = (yp + Dh * xv) * silu_f(z); } }
#pragma unroll
        for (int q = 0; q < 4; ++q) *(f32x4*)(F.out + O_SSMS + so + 4 * q) = s[q];
    }
    __syncthreads();
    if (w < 4) { const int l = w; float v[6]; float ss = 0.f;
#pragma unroll
        for (int k = 0; k < 6; ++k) { v[k] = yg[l * 384 + lane + 64 * k]; ss += v[k] * v[k]; }
        ss = wave_sum(ss); const float rn = rsqrtf(ss * (1.f / 384.f) + EPS);
#pragma unroll
        for (int k = 0; k < 6; ++k) { const int col = lane + 64 * k; F_proj[(row0 + l) * NINP + 512 + 384 * g + col] = f2bf(v[k] * rn * P.in[I_NORMW][384 * g + col]); } }
    __syncthreads();
}

DI void sample_attn_item(const Params& P, const Frame& F, int item) {
    const int tid = F.tid, w = F.w, lane = F.lane;
    const int b = item >> 3, h = item & 7;
    float* qs = (float*)F.lds + w * 256;
    float* ps = qs + 64;
    float* ores = (float*)F.lds + 8 * 256;
    float* lres = ores + 12 * 64;
    const size_t row0 = (size_t)MP + 4 * b;
#pragma unroll 1
    for (int rnd = 0; rnd < 2; ++rnd) {
        const int task = w + 8 * rnd;
        if (task < 12) {
            const int g = task >> 2, l = task & 3;
            const int W = g == 0 ? 128 : (g == 1 ? 512 : 2048), d = g == 0 ? 1 : (g == 1 ? 4 : 16);
            const float* cache = (g == 0 ? P.in[I_C128] : (g == 1 ? P.in[I_C512] : P.in[I_C2048]));
            const int qc = g * 1536 + h * 64;
            qs[lane] = bf2f(F_proj[(row0 + l) * NINP + qc + lane]) * 0.125f;
            asm volatile("s_waitcnt lgkmcnt(0)" ::: "memory");
            float sc[3];
#pragma unroll
            for (int r3 = 0; r3 < 3; ++r3) { const int j = lane + 64 * r3; float dot = -INFINITY;
                if (j <= 128) { const int idx = W + l - d * j; dot = 0.f;
                    if (idx >= W) { const bf16_t* kp = F_proj + (row0 + (idx - W)) * NINP + qc + 512;
#pragma unroll
                        for (int e8 = 0; e8 < 8; ++e8) { float kf[8]; unpack8(*(const u32x4*)(kp + e8 * 8), kf);
#pragma unroll
                            for (int e = 0; e < 8; ++e) dot += kf[e] * qs[e8 * 8 + e]; }
                    } else { const float* kp = cache + (((size_t)b * W + idx) * 2 * 8 + h) * 64;
#pragma unroll
                        for (int e4 = 0; e4 < 16; ++e4) { const f32x4 kk = *(const f32x4*)(kp + e4 * 4); const f32x4 qq = *(const f32x4*)(qs + e4 * 4);
                            dot += (kk[0] * qq[0] + kk[1] * qq[1]) + (kk[2] * qq[2] + kk[3] * qq[3]); } } }
                sc[r3] = dot; }
            const float m = wave_max(fmaxf(fmaxf(sc[0], sc[1]), sc[2]));
            float dsum = 0.f;
#pragma unroll
            for (int r3 = 0; r3 < 3; ++r3) { const float p = __expf(sc[r3] - m); dsum += p; ps[lane + 64 * r3] = p; }
            const float den = wave_sum(dsum);
            asm volatile("s_waitcnt lgkmcnt(0)" ::: "memory");
            const int e4 = lane & 15, sub = lane >> 4;
            f32x4 acc = (f32x4){0.f, 0.f, 0.f, 0.f};
#pragma unroll 11
            for (int j = sub; j <= 128; j += 4) { const int idx = W + l - d * j; const float p = ps[j]; f32x4 vv;
                if (idx >= W) { const u32x2 t = *(const u32x2*)(F_proj + (row0 + (idx - W)) * NINP + qc + 1024 + e4 * 4); vv[0] = bflo(t.x); vv[1] = bfhi(t.x); vv[2] = bflo(t.y); vv[3] = bfhi(t.y); }
                else vv = *(const f32x4*)(cache + ((((size_t)b * W + idx) * 2 + 1) * 8 + h) * 64 + e4 * 4);
                acc += vv * p; }
#pragma unroll
            for (int q = 0; q < 4; ++q) { acc[q] += __shfl_xor(acc[q], 16); acc[q] += __shfl_xor(acc[q], 32); }
            if (sub == 0) *(f32x4*)(ores + task * 64 + e4 * 4) = acc * (1.f / den);
            if (lane == 0) lres[task] = m + __logf(den);
            { const int kv = lane >> 5, e2 = (lane & 31) * 2; const unsigned t = *(const unsigned*)(F_proj + (row0 + l) * NINP + qc + 512 + kv * 512 + e2);
              float* dp = F_newkv + ((((size_t)(4 * b + l) * 3 + g) * 2 + kv) * 8 + h) * 64 + e2; dp[0] = bflo(t); dp[1] = bfhi(t); }
        }
    }
    __syncthreads();
    if (tid < 256) { const int l = tid >> 6, e = tid & 63;
        const float l0 = lres[l], l1 = lres[4 + l], l2 = lres[8 + l], mm = fmaxf(fmaxf(l0, l1), l2);
        const float a0 = __expf(l0 - mm), a1 = __expf(l1 - mm), a2 = __expf(l2 - mm), inv = 1.f / (a0 + a1 + a2);
        const float o = (a0 * ores[l * 64 + e] + a1 * ores[(4 + l) * 64 + e] + a2 * ores[(8 + l) * 64 + e]) * inv;
        F_proj[(row0 + l) * NINP + h * 64 + e] = f2bf(o); }
    __syncthreads();
}

DI void copy_row_bf16_f32(const bf16_t* src, float* dst, int n512, int lane) {
    for (int jj = 0; jj < n512; ++jj) { const int e0 = lane * 8 + 512 * jj; float f[8]; unpack8(*(const u32x4*)(src + e0), f);
        *(f32x4*)(dst + e0) = (f32x4){f[0], f[1], f[2], f[3]}; *(f32x4*)(dst + e0 + 4) = (f32x4){f[4], f[5], f[6], f[7]}; }
}
DI void phase5_copies(const Frame& F) {
    const int gw = F.blk * 8 + F.w, NGW = F.nblk * 8;
    for (int rr = gw; rr < 10752 + 12 + 96; rr += NGW) {
        if (rr < 10752) { int q = rr, g, W; size_t ob;
            if (q < 512) { g = 0; W = 128; ob = O_KV128P; } else if (q < 2560) { q -= 512; g = 1; W = 512; ob = O_KV512P; } else { q -= 2560; g = 2; W = 2048; ob = O_KV2048P; }
            const int b = q / W, i = q % W;
            copy_row_bf16_f32(F_proj + ((size_t)b * SEQ + SEQ - W + i) * NINP + g * 1536 + 512, F.out + ob + ((size_t)b * W + i) * 1024, 2, F.lane);
        } else if (rr < 10764) { const int q = rr - 10752, b = q / 3, i = q % 3;
            copy_row_bf16_f32(F_proj + ((size_t)b * SEQ + SEQ - 3 + i) * NINP + OFF_XBC, F.out + O_CONVP + (size_t)q * 2560, 5, F.lane);
        } else { const int q = rr - 10764, b = q / 3, i = q % 3;
            copy_row_bf16_f32(F_proj + ((size_t)MP + 4 * b + 1 + i) * NINP + OFF_XBC, F.out + O_CONVS + (size_t)q * 2560, 5, F.lane); }
    }
}
DI void phase7_combine(const Frame& F) {
    const int gw = F.blk * 8 + F.w, NGW = F.nblk * 8, lane = F.lane, h = lane >> 3;
    for (int row0 = gw; row0 < MP; row0 += 4 * NGW) {
        float l[4][3]; u32x4 v[4][3];
#pragma unroll
        for (int r = 0; r < 4; ++r) { const int row = row0 + r * NGW; if (row < MP) {
            const float* lp = F_lse + (size_t)row * 24 + h; l[r][0] = lp[0]; l[r][1] = lp[8]; l[r][2] = lp[16];
            const bf16_t* op = F_atto + (size_t)row * 1536 + lane * 8; v[r][0] = *(const u32x4*)op; v[r][1] = *(const u32x4*)(op + 512); v[r][2] = *(const u32x4*)(op + 1024); } }
#pragma unroll
        for (int r = 0; r < 4; ++r) { const int row = row0 + r * NGW; if (row < MP) {
            const float mm = fmaxf(fmaxf(l[r][0], l[r][1]), l[r][2]);
            const float a0 = __expf(l[r][0] - mm), a1 = __expf(l[r][1] - mm), a2 = __expf(l[r][2] - mm), inv = 1.f / (a0 + a1 + a2);
            float f0[8], f1[8], f2[8], o[8]; unpack8(v[r][0], f0); unpack8(v[r][1], f1); unpack8(v[r][2], f2);
#pragma unroll
            for (int e = 0; e < 8; ++e) o[e] = (a0 * f0[e] + a1 * f1[e] + a2 * f2[e]) * inv;
            u32x4 t; t.x = pk2(o[0], o[1]); t.y = pk2(o[2], o[3]); t.z = pk2(o[4], o[5]); t.w = pk2(o[6], o[7]);
            *(u32x4*)(F_proj + (size_t)row * NINP + lane * 8) = t; } }
    }
}
template <int G> DI void kvcopy_group(const float* __restrict__ cache, const float* __restrict__ newkv, float* __restrict__ outp, int blk, int nblk, int tid) {
    constexpr int W = G == 0 ? 128 : (G == 1 ? 512 : 2048);
    const size_t total = (size_t)32 * W * 256, nthreads = (size_t)nblk * 512;
    for (size_t q = (size_t)blk * 512 + tid; q < total; q += nthreads) {
        const int row = (int)(q >> 8), c4 = (int)(q & 255), b = row / W, i = row % W;
        const float* src = (i + 4 < W) ? cache + ((size_t)b * W + i + 4) * 1024 : newkv + ((size_t)(4 * b + (i + 4 - W)) * 3 + G) * 1024;
        *(f32x4*)(outp + ((size_t)b * W + i) * 1024 + c4 * 4) = *(const f32x4*)(src + c4 * 4);
    }
}
DI void phase_kvcopy(const Params& P, const Frame& F) {
    kvcopy_group<0>(P.in[I_C128], F_newkv, F.out + O_KV128S, F.blk, F.nblk, F.tid);
    kvcopy_group<1>(P.in[I_C512], F_newkv, F.out + O_KV512S, F.blk, F.nblk, F.tid);
    kvcopy_group<2>(P.in[I_C2048], F_newkv, F.out + O_KV2048S, F.blk, F.nblk, F.tid);
}

__global__ void __launch_bounds__(512, 2) fwd_megakernel(Params P) {
    extern __shared__ __attribute__((aligned(16))) unsigned char shm[];
    cg::grid_group grid = cg::this_grid();
    Frame F; F.out = P.out; F.ws = P.ws; F.lds = shm; F.tid = threadIdx.x; F.lane = threadIdx.x & 63; F.w = __builtin_amdgcn_readfirstlane(threadIdx.x >> 6); F.nblk = gridDim.x; F.blk = blockIdx.x;

    volatile LAS unsigned* bst = (volatile LAS unsigned*)(LAS unsigned char*)(shm + LDS_BAR_OFF);
    if (threadIdx.x < 2) bst[threadIdx.x] = 0u;
    __syncthreads();
    const XcdBarrier XB = xcd_barrier_post((unsigned*)(P.ws + WS_BAR), bst);
#define GSYNC(k) do { if ((k) == 0) { asm volatile("s_waitcnt vmcnt(0)" ::: "memory"); grid.sync(); } else xcd_barrier(XB); } while (0)
#define PHASE(k, body) do { if ((PHASE_MASK & (1 << (k))) && P.ph_lo <= (k) && (k) < P.ph_hi) { body if (DOUBLE_MASK & (1 << (k))) { GSYNC(1); body } } if (P.ph_lo <= (k) && (k) + 1 < P.ph_hi) GSYNC(k); } while (0)
    PHASE(0, phase_prep(P, F););
    PHASE(1, { zero_f_sample(F); EpiSwiglu E; E.O = F_act; run_gemm(F, F_xn, 1024, F_wgu1, 5632, 1024, E); });
    PHASE(2, { EpiF32 E; E.C = F_f; run_gemm(F, F_act, FF, F_wd1, 1024, FF, E, 4); });
    PHASE(3, phase_rows<0>(P, F););
    PHASE(4, { EpiProj E; E.O = F_proj; E.dtraw = F_dtraw; run_gemm(F, F_xn, 1024, F_win, NINP, 1024, E); });
    PHASE(5, {
        if (SUB_MASK & 1) phase_attn(F, (DOUBLE_SUB & 1) ? 2 : 1);
        if (SUB_MASK & 2) for (int rep = 0; rep < ((DOUBLE_SUB & 2) ? 2 : 1); ++rep) for (int u = F.blk; u < 1024; u += F.nblk) ssd1_unit(P, F, u);
        if (SUB_MASK & 4) for (int u = F.blk; u < 256; u += F.nblk) sample_attn_item(P, F, u);
        if (SUB_MASK & 8) phase5_copies(F); });
    PHASE(6, { phase_scan(F); if (SUB_MASK & 32) for (int u = (F.blk + F.nblk / 2) % F.nblk; u < 128; u += F.nblk) sample_ssd_item(P, F, u); });
    PHASE(7, {
        if (SUB_MASK & 16) for (int rep = 0; rep < ((DOUBLE_SUB & 16) ? 2 : 1); ++rep) for (int u = F.blk; u < 1024; u += F.nblk) ssd3_unit(P, F, u);
        if (SUB_MASK & 64) for (int rep = 0; rep < ((DOUBLE_SUB & 64) ? 2 : 1); ++rep) phase7_combine(F); });
    PHASE(8, { EpiGate<0> E; E.proj = F_proj; E.m1 = F_m1; E.merged = F_xn; run_gemm(F, F_proj, NINP, F_wa, 1024, 512, E); });
    PHASE(9, { EpiGate<1> E; E.proj = F_proj; E.m1 = F_m1; E.merged = F_xn; run_gemm(F, F_proj + 512, NINP, F_wb, 1024, 1536, E); });
    PHASE(10, { EpiF32 E; E.C = F_f; run_gemm(F, F_xn, 1024, F_wo, 1024, 1024, E); });
    PHASE(11, phase_rows<1>(P, F););
    PHASE(12, { zero_f_sample(F); EpiSwiglu E; E.O = F_act; run_gemm(F, F_xn, 1024, F_wgu2, 5632, 1024, E); });
    PHASE(13, { EpiF32 E; E.C = F_f; run_gemm(F, F_act, FF, F_wd2, 1024, FF, E, 4); });
    PHASE(14, { phase_rows<2>(P, F); phase_kvcopy(P, F); });
}

extern "C" void kernel_launch(void* const* d_in, const int* in_sizes, int n_in, void* d_out, int out_size, void* d_ws, size_t ws_size, hipStream_t stream) {
    static int grid_blocks = 0;
    if (grid_blocks == 0) {
        if (n_in != 29 || (size_t)out_size != O_TOTAL || ws_size < WS_END) { fprintf(stderr, "kernel_launch: unexpected shapes: n_in %d out %d ws %zu (need %zu)\n", n_in, out_size, ws_size, (size_t)WS_END); grid_blocks = -1; return; }
        int dev = 0, cus = 0, per_cu = 0;
        hipGetDevice(&dev); hipDeviceGetAttribute(&cus, hipDeviceAttributeMultiprocessorCount, dev);
        if (hipFuncSetAttribute((const void*)fwd_megakernel, hipFuncAttributeMaxDynamicSharedMemorySize, LDS_BYTES) != hipSuccess) { fprintf(stderr, "kernel_launch: hipFuncSetAttribute failed\n"); grid_blocks = -1; return; }
        hipOccupancyMaxActiveBlocksPerMultiprocessor(&per_cu, (const void*)fwd_megakernel, 512, LDS_BYTES);
        if (per_cu < 1) { fprintf(stderr, "kernel_launch: occupancy query says %d blocks per CU\n", per_cu); grid_blocks = -1; return; }
        grid_blocks = cus;
    }
    if (grid_blocks < 0) return;
    if (hipMemsetAsync((char*)d_ws + WS_BAR, 0, 16384, stream) != hipSuccess) { fprintf(stderr, "kernel_launch: memset failed\n"); return; }
    Params p{};
    for (int i = 0; i < 29; ++i) p.in[i] = (const float*)d_in[i];
    p.out = (float*)d_out; p.ws = (unsigned char*)d_ws;
#if N_LAUNCH_PER_PHASE
    for (int ph = 0; ph < NPHASE; ++ph) { p.ph_lo = ph; p.ph_hi = ph + 1; void* args[] = {&p};
        hipLaunchCooperativeKernel((void*)fwd_megakernel, dim3(grid_blocks), dim3(512), args, LDS_BYTES, stream); }
#else
    p.ph_lo = 0; p.ph_hi = NPHASE; void* args[] = {&p};
    hipError_t e = hipLaunchCooperativeKernel((void*)fwd_megakernel, dim3(grid_blocks), dim3(512), args, LDS_BYTES, stream);
    if (e != hipSuccess) fprintf(stderr, "cooperative launch failed: %s (grid %d)\n", hipGetErrorString(e), grid_blocks);
#endif
}
```

```cpp
#include <hip/hip_runtime.h>
#include <hip/hip_cooperative_groups.h>
#include <cstdio>
namespace cg = cooperative_groups;

#define DI __device__ __forceinline__
#define LAS __attribute__((address_space(3)))
typedef unsigned short bf16_t;
typedef short bf16x8 __attribute__((ext_vector_type(8)));
typedef short s16x4 __attribute__((ext_vector_type(4)));
typedef float f32x4 __attribute__((ext_vector_type(4)));
typedef unsigned u32x4 __attribute__((ext_vector_type(4)));
typedef unsigned u32x2 __attribute__((ext_vector_type(2)));

#ifndef SUB_MASK
#define SUB_MASK 0xff
#endif
#ifndef DOUBLE_SUB
#define DOUBLE_SUB 0
#endif
#ifndef DOUBLE_MASK
#define DOUBLE_MASK 0
#endif
#ifndef PHASE_MASK
#define PHASE_MASK 0x7fff
#endif
#ifndef N_LAUNCH_PER_PHASE
#define N_LAUNCH_PER_PHASE 0
#endif

constexpr int D = 1024, SEQ = 8192, MP = 32768, MS = 128, MROWS = MP + MS, MT = 33024;
constexpr int FF = 2816, NIN = 10776, NINP = 11008;
constexpr int OFF_Z = 4608, OFF_XBC = 6144, OFF_DT = 8704, OFF_GATE = 8728;
constexpr int LDS_BAR_OFF = 147456, LDS_BYTES = LDS_BAR_OFF + 16, NPHASE = 15;
constexpr float EPS = 1e-6f;

enum { I_XP = 0, I_XS, I_C128, I_C512, I_C2048, I_SCONV, I_SSSM, I_WIN, I_CONVW, I_CONVB, I_DTB, I_ALOG, I_DSKIP, I_NORMW, I_WA, I_WB, I_WO,
       I_G1, I_U1, I_D1, I_G2, I_U2, I_D2, I_GPRE1, I_GPOST1, I_GPREM, I_GPOSTM, I_GPRE2, I_GPOST2 };
constexpr size_t O_YP = 0, O_YS = 33554432, O_KV128P = 33685504, O_KV512P = 34209792, O_KV2048P = 36306944, O_CONVP = 44695552, O_SSMP = 44726272,
                 O_KV128S = 45512704, O_KV512S = 49707008, O_KV2048S = 66484224, O_CONVS = 133593088, O_SSMS = 133838848, O_TOTAL = 140130304;
constexpr size_t SZ_WGU = (size_t)5632 * 1024 * 2, SZ_WD = (size_t)1024 * 2816 * 2;
constexpr size_t WS_WGU1 = 0, WS_WD1 = WS_WGU1 + SZ_WGU, WS_WGU2 = WS_WD1 + SZ_WD, WS_WD2 = WS_WGU2 + SZ_WGU, WS_WIN = WS_WD2 + SZ_WD,
                 WS_WA = WS_WIN + (size_t)NINP * 1024 * 2, WS_WB = WS_WA + (size_t)1024 * 512 * 2, WS_WO = WS_WB + (size_t)1024 * 1536 * 2,
                 WS_XN = WS_WO + (size_t)1024 * 1024 * 2, WS_DTRAW = WS_XN + (size_t)MT * 1024 * 2, WS_NEWKV = WS_DTRAW + (size_t)MT * 32 * 4,
                 WS_CDEC = WS_NEWKV + (size_t)128 * 3 * 1024 * 4, WS_BAR = WS_CDEC + (size_t)4 * 64 * 24 * 4, WS_PROJ = WS_BAR + 16384,
                 WS_XBCC = WS_PROJ + (size_t)MT * NINP * 2, WS_END = WS_XBCC + (size_t)MP * 2560 * 2;
constexpr size_t WS_ACT = WS_PROJ, WS_F = WS_PROJ + 268435456;
constexpr size_t SC_ATTO = 0, SC_LSE = SC_ATTO + (size_t)MT * 1536 * 2, SC_STATES = SC_LSE + (size_t)MT * 24 * 4, SC_END = SC_STATES + (size_t)4 * 64 * 24 * 8192 * 2;
constexpr size_t SC_M1 = 0;
static_assert(SC_END <= (size_t)67108864 * 4, "scratch too big");
static_assert((size_t)MT * 1024 * 4 <= (size_t)67108864 * 4, "m1 too big");

struct Params { const float* in[29]; float* out; unsigned char* ws; int ph_lo, ph_hi; };

typedef __bf16 bf16x2_t __attribute__((ext_vector_type(2)));
typedef float f32x2_t __attribute__((ext_vector_type(2)));
DI unsigned pk2(float lo, float hi) { const f32x2_t v = {lo, hi}; const bf16x2_t b = __builtin_convertvector(v, bf16x2_t); return __builtin_bit_cast(unsigned, b); }
DI bf16_t f2bf(float x) { return (bf16_t)(pk2(x, 0.f) & 0xffffu); }
DI float bflo(unsigned u) { return __uint_as_float(u << 16); }
DI float bfhi(unsigned u) { return __uint_as_float(u & 0xffff0000u); }
DI float bf2f(bf16_t b) { return __uint_as_float(((unsigned)b) << 16); }
DI float wave_sum(float v) {
#pragma unroll
    for (int o = 1; o < 64; o <<= 1) v += __shfl_xor(v, o);
    return v; }
DI float wave_max(float v) {
#pragma unroll
    for (int o = 1; o < 64; o <<= 1) v = fmaxf(v, __shfl_xor(v, o));
    return v; }
DI float silu_f(float x) { return x * __builtin_amdgcn_rcpf(1.f + __expf(-x)); }
DI float sigmoid_f(float x) { return __builtin_amdgcn_rcpf(1.f + __expf(-x)); }
DI float softplus_f(float x) { return x > 20.f ? x : log1pf(__expf(x)); }
DI void lds_barrier() { asm volatile("s_waitcnt lgkmcnt(0)" ::: "memory"); __builtin_amdgcn_s_barrier(); asm volatile("" ::: "memory"); }
template <int ROWB> DI void tr8(unsigned addr, s16x4 (&a)[4], s16x4 (&b)[4]) {
    asm volatile("ds_read_b64_tr_b16 %0, %8\n\tds_read_b64_tr_b16 %1, %8 offset:%9\n\t"
                 "ds_read_b64_tr_b16 %2, %8 offset:32\n\tds_read_b64_tr_b16 %3, %8 offset:%10\n\t"
                 "ds_read_b64_tr_b16 %4, %8 offset:64\n\tds_read_b64_tr_b16 %5, %8 offset:%11\n\t"
                 "ds_read_b64_tr_b16 %6, %8 offset:96\n\tds_read_b64_tr_b16 %7, %8 offset:%12\n\t"
                 "s_waitcnt lgkmcnt(0)"
                 : "=&v"(a[0]), "=&v"(b[0]), "=&v"(a[1]), "=&v"(b[1]), "=&v"(a[2]), "=&v"(b[2]), "=&v"(a[3]), "=&v"(b[3])
                 : "v"(addr), "n"(16 * ROWB), "n"(16 * ROWB + 32), "n"(16 * ROWB + 64), "n"(16 * ROWB + 96) : "memory");
}
DI f32x4 mfma16(bf16x8 a, bf16x8 b, f32x4 c) { return __builtin_amdgcn_mfma_f32_16x16x32_bf16(a, b, c, 0, 0, 0); }
DI void unpack8(u32x4 v, float (&f)[8]) { f[0] = bflo(v.x); f[1] = bfhi(v.x); f[2] = bflo(v.y); f[3] = bfhi(v.y); f[4] = bflo(v.z); f[5] = bfhi(v.z); f[6] = bflo(v.w); f[7] = bfhi(v.w); }

namespace pg8 {
constexpr int BM = 256, BK = 64, HALF = 128, HTB = HALF * BK * 2, NXCD = 8, WGM = 8;
DI int lds_byte(int r, int c) { const int st = (r >> 4) * 2 + (c >> 5), rr = r & 15, cc = c & 31, ob = rr * 64 + cc * 2; return st * 1024 + (ob ^ (((ob >> 9) & 1) << 5)); }
DI void stage_rc(int b, int& R, int& C) { const int st = b / 1024, sb = b % 1024, swz = sb ^ (((sb >> 9) & 1) << 5); R = (st >> 1) * 16 + swz / 64; C = (st & 1) * 32 + (swz % 64) / 2; }
DI int perm32(int rho) { const int n = rho >> 4, i = rho & 15; return 8 * (i >> 2) + 4 * n + (i & 3); }
struct Unit { int pm, pn, kt0, ntu, split, half; };
struct Gemm { const bf16_t* A; const bf16_t* Bt; int M, N, K, lda; };
struct StaticOrder {
    int nM, nN, nwg, G, c, nt, sl;
    DI void init(int M, int N, int K, int G_, int c_, int sl_) { sl = sl_; nM = M / BM - (sl_ ? 1 : 0); nN = N / BM; nwg = nM * nN; G = G_; c = c_; nt = K / BK; }
    DI bool next(int i, Unit& u) const {
        const long L = (long)i * G + c;
        if (L >= nwg) { if (!sl) return false; const int idx = (int)(L - nwg), ns = nt / sl; if (idx >= nN * ns) return false;
            u.pm = nM; u.pn = idx % nN; u.kt0 = (idx / nN) * sl; u.ntu = sl; u.split = 1; u.half = 1; return true; }
        int wgid = (int)L; { const int q = nwg / NXCD, r = nwg % NXCD, xcd = wgid % NXCD, off = wgid / NXCD; wgid = (xcd < r ? xcd * (q + 1) : r * (q + 1) + (xcd - r) * q) + off; }
        const int nig = WGM * nN, gid = wgid / nig, fm = gid * WGM, gsz = (nM - fm) < WGM ? (nM - fm) : WGM;
        u.pm = fm + ((wgid % nig) % gsz); u.pn = (wgid % nig) / gsz; u.kt0 = 0; u.ntu = nt; u.split = 0; u.half = (u.pm == MP / BM) ? 1 : 0; return true;
    }
};
template <class Epi>
DI void gemm_phase(LAS unsigned char* lds, const Gemm g, const StaticOrder& S, const Epi& E) {
    const int tid = threadIdx.x, wid = __builtin_amdgcn_readfirstlane(tid >> 6), lane = tid & 63, wr = wid >> 2, wc = wid & 3, fr = lane & 15, fq = lane >> 4;
    const int K = g.K, lda = g.lda;
    unsigned voffA[2], voffB[2];
#pragma unroll
    for (int i = 0; i < 2; ++i) { int R, C; stage_rc(tid * 16 + i * 8192, R, C); const int Rb = Epi::PERM ? ((R & ~31) + perm32(R & 31)) : R;
        voffA[i] = (unsigned)(R * lda + C) * 2u; voffB[i] = (unsigned)(Rb * K + C) * 2u; }
    const size_t kstep = (size_t)(BK * 2);
    const size_t hstepA = (size_t)HALF * lda * 2, hstepB = (size_t)HALF * K * 2;
    const size_t tstepA = 2 * hstepA, tstepB = 2 * hstepB;
    const unsigned ldsw = (unsigned)wid * 1024u;
    const int aoff = lds_byte(wr * 64 + fr, fq * 8), boff = lds_byte(wc * 32 + fr, fq * 8);
#define PG8_SA(b, h) (((b) * 2 + (h)) * HTB)
#define PG8_SB(b, h) ((4 + (b) * 2 + (h)) * HTB)
#define PG8_STAGE(bufoff, gbase, voff) do { _Pragma("unroll") for (int _i = 0; _i < 2; ++_i) \
        __builtin_amdgcn_global_load_lds((const unsigned*)((const char*)(gbase) + (voff)[_i]), (LAS unsigned*)(lds + (bufoff) + ldsw + _i * 8192), 16, 0, 0); } while (0)
#define PG8_LDA(dst, b, h) do { _Pragma("unroll") for (int m = 0; m < 4; ++m) _Pragma("unroll") for (int k = 0; k < 2; ++k) dst[m][k] = *(const LAS bf16x8*)(lds + PG8_SA(b, h) + aoff + m * 2048 + k * 1024); } while (0)
#define PG8_LDB(dst, b, h) do { _Pragma("unroll") for (int n = 0; n < 2; ++n) _Pragma("unroll") for (int k = 0; k < 2; ++k) dst[n][k] = *(const LAS bf16x8*)(lds + PG8_SB(b, h) + boff + n * 2048 + k * 1024); } while (0)
#define PG8_MMA(ai, bj, At, Bt) do { __builtin_amdgcn_s_setprio(1); _Pragma("unroll") for (int m = 0; m < 4; ++m) _Pragma("unroll") for (int n = 0; n < 2; ++n) _Pragma("unroll") for (int k = 0; k < 2; ++k) \
        acc[ai][bj][m][n] = __builtin_amdgcn_mfma_f32_16x16x32_bf16(Bt[n][k], At[m][k], acc[ai][bj][m][n], 0, 0, 0); __builtin_amdgcn_s_setprio(0); } while (0)
#define PG8_WAIT_V(n) asm volatile("s_waitcnt vmcnt(" #n ")" ::: "memory")
#define PG8_WAIT_L(n) asm volatile("s_waitcnt lgkmcnt(" #n ")" ::: "memory")
#define PG8_BAR __builtin_amdgcn_s_barrier()
#define PG8_SCHED __builtin_amdgcn_sched_barrier(0)
    Unit cur, nxt; int ui = 0;
    if (!S.next(0, cur)) return;
    f32x4 acc[2][2][4][2];
#pragma unroll
    for (int a = 0; a < 2; ++a)
#pragma unroll
        for (int b = 0; b < 2; ++b)
#pragma unroll
            for (int m = 0; m < 4; ++m)
#pragma unroll
                for (int n = 0; n < 2; ++n) acc[a][b][m][n] = (f32x4){0.f, 0.f, 0.f, 0.f};
    bf16x8 At[4][2], B0[2][2], B1[2][2];
    const char* cA = (const char*)g.A + (size_t)cur.pm * tstepA + (size_t)cur.kt0 * kstep; const char* cB = (const char*)g.Bt + (size_t)cur.pn * tstepB + (size_t)cur.kt0 * kstep;
    PG8_STAGE(PG8_SB(0, 0), cB, voffB); PG8_STAGE(PG8_SA(0, 0), cA, voffA); PG8_STAGE(PG8_SB(0, 1), cB + hstepB, voffB); PG8_STAGE(PG8_SA(0, 1), cA + hstepA, voffA);
    if (wr == 1) PG8_BAR;
    PG8_WAIT_V(4); PG8_BAR;
    PG8_STAGE(PG8_SB(1, 0), cB + kstep, voffB); PG8_STAGE(PG8_SA(1, 0), cA + kstep, voffA); PG8_STAGE(PG8_SB(1, 1), cB + hstepB + kstep, voffB);
    PG8_WAIT_V(6); PG8_BAR;
    for (;;) {
        const bool has_next = S.next(ui + 1, nxt);
        const char* nA = has_next ? (const char*)g.A + (size_t)nxt.pm * tstepA + (size_t)nxt.kt0 * kstep : cA; const char* nB = has_next ? (const char*)g.Bt + (size_t)nxt.pn * tstepB + (size_t)nxt.kt0 * kstep : cB;
        const int nt = cur.ntu; const bool full = !cur.half;
        for (int t = 0; t < nt; t += 2) {
            const bool last = (t == nt - 2);
            const char* a1 = cA + (size_t)(t + 1) * kstep;
            const char* a2 = last ? nA : cA + (size_t)(t + 2) * kstep; const char* b2 = last ? nB : cB + (size_t)(t + 2) * kstep;
            const char* a3 = a2 + kstep; const char* b3 = b2 + kstep;
            PG8_LDB(B0, 0, 0); PG8_SCHED; PG8_LDA(At, 0, 0); PG8_STAGE(PG8_SA(1, 1), a1 + hstepA, voffA);
            PG8_WAIT_L(8); PG8_BAR; PG8_WAIT_L(0); PG8_MMA(0, 0, At, B0); PG8_BAR; PG8_SCHED;
            PG8_LDB(B1, 0, 1); PG8_STAGE(PG8_SB(0, 0), b2, voffB);
            PG8_BAR; PG8_WAIT_L(0); PG8_MMA(0, 1, At, B1); PG8_BAR;
            PG8_LDA(At, 0, 1); PG8_STAGE(PG8_SA(0, 0), a2, voffA);
            PG8_BAR; PG8_WAIT_L(0); if (full) PG8_MMA(1, 0, At, B0); PG8_BAR; PG8_SCHED;
            PG8_STAGE(PG8_SB(0, 1), b2 + hstepB, voffB);
            PG8_WAIT_V(6); PG8_BAR; if (full) PG8_MMA(1, 1, At, B1); PG8_BAR;
            PG8_LDB(B0, 1, 0); PG8_SCHED; PG8_LDA(At, 1, 0); PG8_STAGE(PG8_SA(0, 1), a2 + hstepA, voffA);
            PG8_WAIT_L(8); PG8_BAR; PG8_WAIT_L(0); PG8_MMA(0, 0, At, B0); PG8_BAR; PG8_SCHED;
            PG8_LDB(B1, 1, 1); PG8_STAGE(PG8_SB(1, 0), b3, voffB);
            PG8_BAR; PG8_WAIT_L(0); PG8_MMA(0, 1, At, B1); PG8_BAR;
            PG8_LDA(At, 1, 1); PG8_STAGE(PG8_SA(1, 0), a3, voffA);
            PG8_BAR; PG8_WAIT_L(0); if (full) PG8_MMA(1, 0, At, B0); PG8_BAR; PG8_SCHED;
            PG8_STAGE(PG8_SB(1, 1), b3 + hstepB, voffB);
            PG8_WAIT_V(6); PG8_BAR; if (full) PG8_MMA(1, 1, At, B1); PG8_BAR;
        }
        E(acc, cur, wr, wc, fr, fq);
        if (!has_next) break;
#pragma unroll
        for (int a = 0; a < 2; ++a)
#pragma unroll
            for (int b = 0; b < 2; ++b)
#pragma unroll
                for (int m = 0; m < 4; ++m)
#pragma unroll
                    for (int n = 0; n < 2; ++n) acc[a][b][m][n] = (f32x4){0.f, 0.f, 0.f, 0.f};
        cur = nxt; cA = nA; cB = nB; ++ui;
    }
    PG8_WAIT_V(0);
    if (wr == 0) PG8_BAR;
    PG8_BAR;
#undef PG8_SA
#undef PG8_SB
#undef PG8_STAGE
#undef PG8_LDA
#undef PG8_LDB
#undef PG8_MMA
#undef PG8_WAIT_V
#undef PG8_WAIT_L
#undef PG8_BAR
#undef PG8_SCHED
}
}
using pg8::Unit;

struct EpiSwiglu {
    static constexpr bool PERM = true; bf16_t* O;
    DI void operator()(const f32x4 (&acc)[2][2][4][2], const Unit& u, int wr, int wc, int fr, int fq) const {
        const int row0 = u.pm * 256 + wr * 64 + fr, col0 = u.pn * 128 + wc * 32 + 8 * fq;
#pragma unroll
        for (int ai = 0; ai < 2; ++ai) if (ai == 0 || !u.half)
#pragma unroll
            for (int m = 0; m < 4; ++m) { bf16_t* rowp = O + (size_t)(row0 + ai * 128 + m * 16) * FF + col0;
                const f32x4 g0 = acc[ai][0][m][0], g1 = acc[ai][0][m][1], u0 = acc[ai][1][m][0], u1 = acc[ai][1][m][1];
                u32x4 w; w.x = pk2(silu_f(g0[0]) * u0[0], silu_f(g0[1]) * u0[1]); w.y = pk2(silu_f(g0[2]) * u0[2], silu_f(g0[3]) * u0[3]);
                w.z = pk2(silu_f(g1[0]) * u1[0], silu_f(g1[1]) * u1[1]); w.w = pk2(silu_f(g1[2]) * u1[2], silu_f(g1[3]) * u1[3]);
                *(u32x4*)rowp = w; }
    }
};
struct EpiProj {
    static constexpr bool PERM = true; bf16_t* O; float* dtraw;
    DI void operator()(const f32x4 (&acc)[2][2][4][2], const Unit& u, int wr, int wc, int fr, int fq) const {
        const int row0 = u.pm * 256 + wr * 64 + fr, col0 = u.pn * 256 + wc * 32 + 8 * fq;
#pragma unroll
        for (int ai = 0; ai < 2; ++ai) if (ai == 0 || !u.half)
#pragma unroll
            for (int m = 0; m < 4; ++m) { const int row = row0 + ai * 128 + m * 16; bf16_t* rowp = O + (size_t)row * NINP + col0;
#pragma unroll
                for (int bj = 0; bj < 2; ++bj) { const f32x4 v0 = acc[ai][bj][m][0], v1 = acc[ai][bj][m][1];
                    u32x4 w; w.x = pk2(v0[0], v0[1]); w.y = pk2(v0[2], v0[3]); w.z = pk2(v1[0], v1[1]); w.w = pk2(v1[2], v1[3]);
                    *(u32x4*)(rowp + bj * 128) = w;
                    if (bj == 0 && u.pn == 34 && wc == 0 && fq < 3) { float* dp = dtraw + (size_t)row * 32 + 8 * fq; *(f32x4*)dp = v0; *(f32x4*)(dp + 4) = v1; } } }
    }
};
struct EpiF32 {
    static constexpr bool PERM = false; float* C;
    DI void operator()(const f32x4 (&acc)[2][2][4][2], const Unit& u, int wr, int wc, int fr, int fq) const {
        const int row0 = u.pm * 256 + wr * 64 + fr, col0 = u.pn * 256 + wc * 32 + 4 * fq;
        if (u.split) {
#pragma unroll
            for (int m = 0; m < 4; ++m) { float* rowp = C + (size_t)(row0 + m * 16) * D + col0;
#pragma unroll
                for (int bj = 0; bj < 2; ++bj)
#pragma unroll
                    for (int n = 0; n < 2; ++n)
#pragma unroll
                        for (int e = 0; e < 4; ++e) unsafeAtomicAdd(rowp + bj * 128 + n * 16 + e, acc[0][bj][m][n][e]); }
            return; }
#pragma unroll
        for (int ai = 0; ai < 2; ++ai) if (ai == 0 || !u.half)
#pragma unroll
            for (int m = 0; m < 4; ++m) { float* rowp = C + (size_t)(row0 + ai * 128 + m * 16) * D + col0;
#pragma unroll
                for (int bj = 0; bj < 2; ++bj)
#pragma unroll
                    for (int n = 0; n < 2; ++n) *(f32x4*)(rowp + bj * 128 + n * 16) = acc[ai][bj][m][n]; }
    }
};
template <int SECOND> struct EpiGate {
    static constexpr bool PERM = false; const bf16_t* proj; float* m1; bf16_t* merged;
    DI void operator()(const f32x4 (&acc)[2][2][4][2], const Unit& u, int wr, int wc, int fr, int fq) const {
        const int row0 = u.pm * 256 + wr * 64 + fr, col0 = u.pn * 256 + wc * 32 + 4 * fq;
#pragma unroll
        for (int ai = 0; ai < 2; ++ai) if (ai == 0 || !u.half)
#pragma unroll
            for (int m = 0; m < 4; ++m) { const size_t row = (size_t)(row0 + ai * 128 + m * 16);
#pragma unroll
                for (int bj = 0; bj < 2; ++bj)
#pragma unroll
                    for (int n = 0; n < 2; ++n) { const int c = col0 + bj * 128 + n * 16; const f32x4 a = acc[ai][bj][m][n];
                        const u32x2 gv = *(const u32x2*)(proj + row * NINP + OFF_GATE + SECOND * 1024 + c);
                        f32x4 r; r[0] = sigmoid_f(bflo(gv.x)) * a[0]; r[1] = sigmoid_f(bfhi(gv.x)) * a[1]; r[2] = sigmoid_f(bflo(gv.y)) * a[2]; r[3] = sigmoid_f(bfhi(gv.y)) * a[3];
                        if (SECOND == 0) *(f32x4*)(m1 + row * D + c) = r;
                        else { const f32x4 p = *(const f32x4*)(m1 + row * D + c); u32x2 o; o.x = pk2(p[0] + r[0], p[1] + r[1]); o.y = pk2(p[2] + r[2], p[3] + r[3]); *(u32x2*)(merged + row * D + c) = o; } } }
    }
};

#define XB_TMO      128
#define XB_XCNT(j)  (256  + 64 * (j))
#define XB_XSUB(j)  (1280 + 64 * (j))
#define XB_XGEN(j)  (2304 + 64 * (j))
#define XB_TOP      3328
#define XB_TOPGEN   3392
#define XCD_BAR_WORDS 3456
#define XB_SPIN_CAP (1u << 18)
DI unsigned xb_ld(unsigned* p)              { return __hip_atomic_load(p, __ATOMIC_RELAXED, __HIP_MEMORY_SCOPE_AGENT); }
DI unsigned xb_add(unsigned* p, unsigned v) { return __hip_atomic_fetch_add(p, v, __ATOMIC_RELAXED, __HIP_MEMORY_SCOPE_AGENT); }
DI unsigned xb_xcc_id() { return (unsigned)__builtin_amdgcn_s_getreg((3 << 11) | 20) & 0xFu; }
#define XB_SPIN(cond, bar) do { unsigned _sp = 0; while (cond) { __builtin_amdgcn_s_sleep(1); \
    if ((++_sp & 255u) == 0u) { if (xb_ld(&(bar)[XB_TMO])) break; if (_sp > XB_SPIN_CAP) { atomicAdd(&(bar)[XB_TMO], 1u); break; } } } } while (0)
struct XcdBarrier { unsigned* bar; unsigned x; volatile LAS unsigned* st; };
DI XcdBarrier xcd_barrier_post(unsigned* bar, volatile LAS unsigned* st) {
    XcdBarrier b; b.bar = bar; b.x = xb_xcc_id(); b.st = st;
    if (threadIdx.x == 0) (void)xb_add(&bar[XB_XCNT(b.x)], 1u);
    return b;
}
DI void xcd_barrier_complete(unsigned* bar, unsigned x, unsigned& nloc, unsigned& nx) {
    const unsigned G = gridDim.x * gridDim.y * gridDim.z;
    unsigned sum, cnt, mine, sp = 0u;
    for (;;) {
        sum = 0u; cnt = 0u; mine = 0u;
#pragma unroll
        for (unsigned j = 0; j < 16; ++j) { const unsigned c = xb_ld(&bar[XB_XCNT(j)]); sum += c; cnt += (c > 0u) ? 1u : 0u; mine = (j == x) ? c : mine; }
        if (sum == G) break;
        __builtin_amdgcn_s_sleep(1);
        if ((++sp & 255u) == 0u) { if (xb_ld(&bar[XB_TMO])) break; if (sp > XB_SPIN_CAP) { atomicAdd(&bar[XB_TMO], 1u); break; } }
    }
    nloc = mine > 0u ? mine : 1u; nx = cnt > 0u ? cnt : 1u;
}
DI void xcd_barrier(const XcdBarrier& b) {
    asm volatile("s_waitcnt vmcnt(0)" ::: "memory");
    __syncthreads();
    if (threadIdx.x == 0) {
        unsigned* bar = b.bar;
        __builtin_amdgcn_s_waitcnt(0);
        unsigned nloc = b.st[0], nx = b.st[1];
        if (nloc == 0u) { xcd_barrier_complete(bar, b.x, nloc, nx); b.st[0] = nloc; b.st[1] = nx; }
        const unsigned old = xb_add(&bar[XB_XSUB(b.x)], 1u);
        const unsigned gen = old / nloc;
        if (old + 1u == (gen + 1u) * nloc) {
            __builtin_amdgcn_fence(__ATOMIC_RELEASE, "agent");
            asm volatile("s_waitcnt vmcnt(0)" ::: "memory");
            const unsigned og = xb_add(&bar[XB_TOP], 1u);
            const unsigned tg = og / nx;
            if (og + 1u == (tg + 1u) * nx) xb_add(&bar[XB_TOPGEN], 1u);
            else XB_SPIN(xb_ld(&bar[XB_TOPGEN]) == tg, bar);
            __builtin_amdgcn_fence(__ATOMIC_ACQUIRE, "agent");
            xb_add(&bar[XB_XGEN(b.x)], 1u);
            asm volatile("s_waitcnt vmcnt(0)" ::: "memory");
        } else {
            XB_SPIN(xb_ld(&bar[XB_XGEN(b.x)]) == gen, bar);
            __builtin_amdgcn_fence(__ATOMIC_ACQUIRE, "agent");
            asm volatile("s_waitcnt vmcnt(0)" ::: "memory");
        }
    }
    __syncthreads();
}

struct Frame {
    float* out; unsigned char* ws; unsigned char* lds; int tid, lane, w, nblk, blk;
};
#define F_wgu1 ((bf16_t*)(F.ws + WS_WGU1))
#define F_wd1 ((bf16_t*)(F.ws + WS_WD1))
#define F_wgu2 ((bf16_t*)(F.ws + WS_WGU2))
#define F_wd2 ((bf16_t*)(F.ws + WS_WD2))
#define F_win ((bf16_t*)(F.ws + WS_WIN))
#define F_wa ((bf16_t*)(F.ws + WS_WA))
#define F_wb ((bf16_t*)(F.ws + WS_WB))
#define F_wo ((bf16_t*)(F.ws + WS_WO))
#define F_xn ((bf16_t*)(F.ws + WS_XN))
#define F_proj ((bf16_t*)(F.ws + WS_PROJ))
#define F_xbcc ((bf16_t*)(F.ws + WS_XBCC))
#define F_act ((bf16_t*)(F.ws + WS_ACT))
#define F_dtraw ((float*)(F.ws + WS_DTRAW))
#define F_newkv ((float*)(F.ws + WS_NEWKV))
#define F_cdec ((float*)(F.ws + WS_CDEC))
#define F_f ((float*)(F.ws + WS_F))
#define F_h (F.out)
#define F_sc ((unsigned char*)(F.out + O_KV2048S))
#define F_atto ((bf16_t*)(F_sc + SC_ATTO))
#define F_lse ((float*)(F_sc + SC_LSE))
#define F_states ((bf16_t*)(F_sc + SC_STATES))
#define F_m1 ((float*)(F_sc + SC_M1))

template <class Epi> DI void run_gemm(const Frame& F, const bf16_t* A, int lda, const bf16_t* Bt, int N, int K, const Epi& E, int split_sl = 0) {
    pg8::Gemm g; g.A = A; g.Bt = Bt; g.M = MT; g.N = N; g.K = K; g.lda = lda;
    pg8::StaticOrder S; S.init(MT, N, K, F.nblk, F.blk, split_sl);
    pg8::gemm_phase<Epi>((LAS unsigned char*)F.lds, g, S, E);
}

DI void zero_f_sample(const Frame& F) {
    f32x4* p = (f32x4*)(F_f + (size_t)MP * D);
    for (int i = F.blk * 512 + F.tid; i < 128 * 256; i += F.nblk * 512) p[i] = (f32x4){0.f, 0.f, 0.f, 0.f};
}
DI void transpose_item(const float* __restrict__ W, int K, int N, int NP, bf16_t* __restrict__ WT, float* scr, int item, int lane, int kind) {
    const int nblk = NP / 32, kb = item / nblk, nb = item % nblk, k0 = 64 * kb, n0 = 32 * nb;
    const int nn = n0 + (lane & 31);
    float tv[32];
#pragma unroll
    for (int i = 0; i < 32; ++i) { const int kk = 2 * i + (lane >> 5); tv[i] = nn < N ? W[(size_t)(k0 + kk) * N + nn] : 0.f; }
#pragma unroll
    for (int i = 0; i < 32; ++i) { const int kk = 2 * i + (lane >> 5); scr[kk * 33 + (lane & 31)] = tv[i]; }
    asm volatile("s_waitcnt lgkmcnt(0)" ::: "memory");
    const int c = lane & 7;
#pragma unroll
    for (int j = 0; j < 4; ++j) { const int n = (lane >> 3) + 8 * j; const float* s = scr + (8 * c) * 33 + n;
        u32x4 o; o.x = pk2(s[0 * 33], s[1 * 33]); o.y = pk2(s[2 * 33], s[3 * 33]); o.z = pk2(s[4 * 33], s[5 * 33]); o.w = pk2(s[6 * 33], s[7 * 33]);
        const int ng = n0 + n; const int row = kind == 0 ? ng : ((ng >> 7) * 256 + (ng & 127) + (kind == 2 ? 128 : 0));
        *(u32x4*)(WT + (size_t)row * K + k0 + 8 * c) = o; }
    asm volatile("s_waitcnt lgkmcnt(0)" ::: "memory");
}
DI void ld_row(const float* p, int lane, f32x4 (&v)[4]) { const f32x4* q = (const f32x4*)p + lane;
#pragma unroll
    for (int j = 0; j < 4; ++j) v[j] = q[64 * j]; }
DI float row_sumsq(const f32x4 (&v)[4]) { float s = 0.f;
#pragma unroll
    for (int j = 0; j < 4; ++j) s += (v[j][0] * v[j][0] + v[j][1] * v[j][1]) + (v[j][2] * v[j][2] + v[j][3] * v[j][3]);
    return wave_sum(s); }
DI void st_row_bf16(bf16_t* o, int lane, const f32x4 (&v)[4]) { u32x2* q = (u32x2*)o + lane;
#pragma unroll
    for (int j = 0; j < 4; ++j) { u32x2 t; t.x = pk2(v[j][0], v[j][1]); t.y = pk2(v[j][2], v[j][3]); q[64 * j] = t; } }
DI void st_row_f32(float* o, int lane, const f32x4 (&v)[4]) { f32x4* q = (f32x4*)o + lane;
#pragma unroll
    for (int j = 0; j < 4; ++j) q[64 * j] = v[j]; }

DI void phase_prep(const Params& P, const Frame& F) {
    float* scr = (float*)F.lds + F.w * (64 * 33 + 32);
    const int gw = F.blk * 8 + F.w, NGW = F.nblk * 8;
    constexpr int I_FU = 16 * 88, I_FD = 44 * 32, I_IN = 16 * (NINP / 32), I_A = 8 * 32, I_B = 24 * 32, I_O = 16 * 32;
    constexpr int NITEMS = 4 * I_FU + 2 * I_FD + I_IN + I_A + I_B + I_O;
    for (int it = gw; it < NITEMS; it += NGW) {
        int r = it;
        if (r < I_FU) { transpose_item(P.in[I_G1], 1024, FF, FF, F_wgu1, scr, r, F.lane, 1); continue; } r -= I_FU;
        if (r < I_FU) { transpose_item(P.in[I_U1], 1024, FF, FF, F_wgu1, scr, r, F.lane, 2); continue; } r -= I_FU;
        if (r < I_FU) { transpose_item(P.in[I_G2], 1024, FF, FF, F_wgu2, scr, r, F.lane, 1); continue; } r -= I_FU;
        if (r < I_FU) { transpose_item(P.in[I_U2], 1024, FF, FF, F_wgu2, scr, r, F.lane, 2); continue; } r -= I_FU;
        if (r < I_FD) { transpose_item(P.in[I_D1], FF, 1024, 1024, F_wd1, scr, r, F.lane, 0); continue; } r -= I_FD;
        if (r < I_FD) { transpose_item(P.in[I_D2], FF, 1024, 1024, F_wd2, scr, r, F.lane, 0); continue; } r -= I_FD;
        if (r < I_IN) { transpose_item(P.in[I_WIN], 1024, NIN, NINP, F_win, scr, r, F.lane, 0); continue; } r -= I_IN;
        if (r < I_A) { transpose_item(P.in[I_WA], 512, 1024, 1024, F_wa, scr, r, F.lane, 0); continue; } r -= I_A;
        if (r < I_B) { transpose_item(P.in[I_WB], 1536, 1024, 1024, F_wb, scr, r, F.lane, 0); continue; } r -= I_B;
        transpose_item(P.in[I_WO], 1024, 1024, 1024, F_wo, scr, r, F.lane, 0);
    }
    f32x4 g[4]; ld_row(P.in[I_GPRE1], F.lane, g);
    f32x4 v[4], vn[4];
    auto src_of = [&](int row) { return row < MP ? P.in[I_XP] + (size_t)row * D : P.in[I_XS] + (size_t)(row - MP) * D; };
    if (gw < MROWS) ld_row(src_of(gw), F.lane, v);
    for (int row = gw; row < MT; row += NGW) {
        const int nrow = row + NGW;
        if (nrow < MROWS) ld_row(src_of(nrow), F.lane, vn);
        if (row < MROWS) { const float rn = rsqrtf(row_sumsq(v) * (1.f / D) + EPS);
#pragma unroll
            for (int j = 0; j < 4; ++j) v[j] = v[j] * rn * g[j];
        } else {
#pragma unroll
            for (int j = 0; j < 4; ++j) v[j] = (f32x4){0.f, 0.f, 0.f, 0.f}; }
        st_row_bf16(F_xn + (size_t)row * D, F.lane, v);
#pragma unroll
        for (int j = 0; j < 4; ++j) v[j] = vn[j];
    }
}

template <int MODE> DI void phase_rows(const Params& P, const Frame& F) {
    const int gw = F.blk * 8 + F.w, NGW = F.nblk * 8;
    f32x4 gp[4], gn[4];
    ld_row(P.in[MODE == 0 ? I_GPOST1 : (MODE == 1 ? I_GPOSTM : I_GPOST2)], F.lane, gp);
    if (MODE < 2) ld_row(P.in[MODE == 0 ? I_GPREM : I_GPRE2], F.lane, gn);
    const float sc = MODE == 1 ? 1.f : 0.5f;
    f32x4 f[4], x[4], fn[4], xq[4];
    auto load_row = [&](int row, f32x4 (&ff)[4], f32x4 (&xx)[4]) {
        ld_row(F_f + (size_t)row * D, F.lane, ff);
        if (MODE == 0) ld_row(row < MP ? P.in[I_XP] + (size_t)row * D : P.in[I_XS] + (size_t)(row - MP) * D, F.lane, xx);
        else ld_row(F_h + (size_t)row * D, F.lane, xx); };
    if (gw < MROWS) load_row(gw, f, x);
    for (int row = gw; row < MROWS; row += NGW) {
        const int nrow = row + NGW;
        if (nrow < MROWS) load_row(nrow, fn, xq);
        const float rn = rsqrtf(row_sumsq(f) * (1.f / D) + EPS) * sc;
#pragma unroll
        for (int j = 0; j < 4; ++j) x[j] = x[j] + f[j] * rn * gp[j];
        st_row_f32(F_h + (size_t)row * D, F.lane, x);
        if (MODE < 2) {
            const float r2 = rsqrtf(row_sumsq(x) * (1.f / D) + EPS);
#pragma unroll
            for (int j = 0; j < 4; ++j) x[j] = x[j] * r2 * gn[j];
            st_row_bf16(F_xn + (size_t)row * D, F.lane, x);
        }
#pragma unroll
        for (int j = 0; j < 4; ++j) { f[j] = fn[j]; x[j] = xq[j]; }
    }
}

struct AttnRegs { u32x4 kv[4], vv[4]; bf16x8 qf[2]; };
DI void attn_decode(int unit, int& b, int& g, int& h, int& dil, int& r, int& n) {
    const int blk = unit & 63; h = (unit >> 6) & 7; const int bg = unit >> 9; g = bg % 3; b = bg / 3;
    dil = g == 0 ? 1 : (g == 1 ? 4 : 16); const int nb = 64 / dil; r = blk / nb; n = blk % nb;
}
DI void attn_fetch(const Frame& F, int unit, AttnRegs& R) {
    int b, g, h, dil, r, n; attn_decode(unit, b, g, h, dil, r, n);
    const bf16_t* proj = F_proj + (size_t)b * SEQ * NINP;
    const int qc = g * 1536 + h * 64, kc = qc + 512, vc = qc + 1024;
#pragma unroll
    for (int i = 0; i < 4; ++i) {
        const int idx = F.tid + 512 * i, key = idx >> 3, ch = idx & 7;
        const int ck = (n - 1) * 128 + key;
        R.kv[i] = (u32x4){0u, 0u, 0u, 0u}; R.vv[i] = (u32x4){0u, 0u, 0u, 0u};
        if (ck >= 0) { const bf16_t* rowp = proj + ((size_t)ck * dil + r) * NINP; R.kv[i] = *(const u32x4*)(rowp + kc + ch * 8); R.vv[i] = *(const u32x4*)(rowp + vc + ch * 8); }
    }
    const int qi = (F.tid >> 6) * 16 + (F.lane & 15), quad = F.lane >> 4;
    const size_t qtok = (size_t)(n * 128 + qi) * dil + r;
#pragma unroll
    for (int ks = 0; ks < 2; ++ks) R.qf[ks] = *(const bf16x8*)(proj + qtok * NINP + qc + ks * 32 + quad * 8);
}
DI void phase_attn(const Frame& F, int nrep) {
    const int tid = F.tid;
    bf16_t* Ks = (bf16_t*)F.lds;
    bf16_t* Vs = Ks + 256 * 72;
    const int total = 6144 * nrep;
    AttnRegs R;
    if (F.blk < total) attn_fetch(F, F.blk % 6144, R);
    for (int uu = F.blk; uu < total; uu += F.nblk) {
        const int unit = uu % 6144;
        int b, g, h, dil, r, n; attn_decode(unit, b, g, h, dil, r, n);
#pragma unroll
        for (int i = 0; i < 4; ++i) {
            const int idx = tid + 512 * i, key = idx >> 3, ch = idx & 7;
            *(u32x4*)(Ks + key * 72 + ch * 8) = R.kv[i];
            *(u32x4*)(Vs + key * 72 + ch * 8) = R.vv[i];
        }
        const bf16x8 qf0 = R.qf[0], qf1 = R.qf[1];
        lds_barrier();
        if (uu + F.nblk < total) attn_fetch(F, (uu + F.nblk) % 6144, R);
        const int w = tid >> 6, lane = F.lane, l15 = lane & 15, quad = lane >> 4;
        const int qi = w * 16 + l15;
        const size_t qtok = (size_t)(n * 128 + qi) * dil + r;
        const int kt0 = w & ~1;
        const unsigned vbase = (unsigned)(size_t)Vs + (unsigned)((quad * 4 + (l15 >> 2)) * 144 + (l15 & 3) * 8);
        f32x4 s[10];
#pragma unroll
        for (int t = 0; t < 10; ++t) { s[t] = (f32x4){0.f, 0.f, 0.f, 0.f};
            const bf16x8 kf0 = *(const bf16x8*)(Ks + ((kt0 + t) * 16 + l15) * 72 + quad * 8), kf1 = *(const bf16x8*)(Ks + ((kt0 + t) * 16 + l15) * 72 + 32 + quad * 8);
            s[t] = mfma16(kf0, qf0, s[t]); s[t] = mfma16(kf1, qf1, s[t]); }
        float m = -INFINITY;
#pragma unroll
        for (int t = 0; t < 10; ++t)
#pragma unroll
            for (int jj = 0; jj < 4; ++jj) { const int kj = (kt0 + t) * 16 + quad * 4 + jj; const bool valid = (kj >= qi) && (kj <= qi + 128) && (n > 0 || kj >= 128);
                const float v = valid ? s[t][jj] : -INFINITY; s[t][jj] = v; m = fmaxf(m, v); }
        m = fmaxf(m, __shfl_xor(m, 16)); m = fmaxf(m, __shfl_xor(m, 32));
        const float sc = 0.125f * 1.4426950408889634f;
        float den = 0.f;
#pragma unroll
        for (int t = 0; t < 10; ++t)
#pragma unroll
            for (int jj = 0; jj < 4; ++jj) { const float p = __builtin_amdgcn_exp2f((s[t][jj] - m) * sc); s[t][jj] = p; den += p; }
        den += __shfl_xor(den, 16); den += __shfl_xor(den, 32);
        f32x4 o[4];
#pragma unroll
        for (int et = 0; et < 4; ++et) o[et] = (f32x4){0.f, 0.f, 0.f, 0.f};
#pragma unroll
        for (int sg = 0; sg < 5; ++sg) {
            u32x4 pw; pw.x = pk2(s[2 * sg][0], s[2 * sg][1]); pw.y = pk2(s[2 * sg][2], s[2 * sg][3]); pw.z = pk2(s[2 * sg + 1][0], s[2 * sg + 1][1]); pw.w = pk2(s[2 * sg + 1][2], s[2 * sg + 1][3]);
            const bf16x8 pf = __builtin_bit_cast(bf16x8, pw);
            const int kb = (kt0 + 2 * sg) * 16;
            s16x4 lo[4], hi[4];
            tr8<144>(vbase + (unsigned)(kb * 144), lo, hi);
#pragma unroll
            for (int et = 0; et < 4; ++et) { const bf16x8 vf = __builtin_shufflevector(lo[et], hi[et], 0, 1, 2, 3, 4, 5, 6, 7); o[et] = mfma16(vf, pf, o[et]); }
        }
        const float inv = 1.f / den;
        const size_t grow = (size_t)b * SEQ + qtok;
        bf16_t* op = F_atto + grow * 1536 + g * 512 + h * 64 + quad * 4;
#pragma unroll
        for (int et = 0; et < 4; ++et) { u32x2 t; t.x = pk2(o[et][0] * inv, o[et][1] * inv); t.y = pk2(o[et][2] * inv, o[et][3] * inv); *(u32x2*)(op + et * 16) = t; }
        if (quad == 0) F_lse[grow * 24 + g * 8 + h] = m * 0.125f + __logf(den);
        lds_barrier();
    }
}

template <int NCOLS>
DI void conv_stage(const bf16_t* __restrict__ src, bool has_prev, const float* __restrict__ cw, const float* __restrict__ cb, bf16_t* dst, int ld, const float* dt_h, const float* cs_h, bf16_t* __restrict__ gdst, int tid) {
    constexpr int nch = NCOLS / 8, nseg = 512 / nch, rps = 128 / nseg;
    const int ch = tid % nch, seg = tid / nch, j0 = seg * rps;
    float wt[4][8], bias[8], xm[3][8];
#pragma unroll
    for (int t = 0; t < 4; ++t) { const f32x4 a = *(const f32x4*)(cw + t * 2560 + ch * 8), c = *(const f32x4*)(cw + t * 2560 + ch * 8 + 4);
        wt[t][0] = a[0]; wt[t][1] = a[1]; wt[t][2] = a[2]; wt[t][3] = a[3]; wt[t][4] = c[0]; wt[t][5] = c[1]; wt[t][6] = c[2]; wt[t][7] = c[3]; }
    { const f32x4 a = *(const f32x4*)(cb + ch * 8), c = *(const f32x4*)(cb + ch * 8 + 4);
        bias[0] = a[0]; bias[1] = a[1]; bias[2] = a[2]; bias[3] = a[3]; bias[4] = c[0]; bias[5] = c[1]; bias[6] = c[2]; bias[7] = c[3]; }
#pragma unroll
    for (int k = 0; k < 3; ++k) { const int j = j0 - 3 + k;
        if (j >= 0 || has_prev) { const u32x4 v = *(const u32x4*)(src + (ptrdiff_t)j * NINP + ch * 8); unpack8(v, xm[k]); }
        else {
#pragma unroll
            for (int e = 0; e < 8; ++e) xm[k][e] = 0.f; } }
    const float cl = dt_h ? cs_h[127] : 0.f;
#pragma unroll
    for (int r = 0; r < rps; ++r) { const int j = j0 + r; float x0[8], y[8];
        { const u32x4 v = *(const u32x4*)(src + (ptrdiff_t)j * NINP + ch * 8); unpack8(v, x0); }
#pragma unroll
        for (int e = 0; e < 8; ++e) { const float t = bias[e] + wt[0][e] * xm[0][e] + wt[1][e] * xm[1][e] + wt[2][e] * xm[2][e] + wt[3][e] * x0[e]; y[e] = silu_f(t); }
        { u32x4 o; o.x = pk2(y[0], y[1]); o.y = pk2(y[2], y[3]); o.z = pk2(y[4], y[5]); o.w = pk2(y[6], y[7]); *(u32x4*)(gdst + (size_t)j * 2560 + ch * 8) = o; }
        if (dst) { const float sc = dt_h ? dt_h[j] * __expf(cl - cs_h[j]) : 1.f;
#pragma unroll
            for (int e = 0; e < 8; ++e) dst[(ch * 8 + e) * ld + j] = f2bf(y[e] * sc); }
#pragma unroll
        for (int e = 0; e < 8; ++e) { xm[0][e] = xm[1][e]; xm[1][e] = xm[2][e]; xm[2][e] = x0[e]; }
    }
}
DI void dtcs_stage(const float* dtraw0, const float* dt_bias6, const float* a_log6, float* dt_s, float* cs_s, int w, int lane) {
    if (w < 6) { const float bias = dt_bias6[w], A = -__expf(a_log6[w]);
        const int j = 2 * lane; const float r0 = dtraw0[(size_t)j * 32 + w], r1 = dtraw0[(size_t)(j + 1) * 32 + w];
        const float d0 = softplus_f(r0 + bias), d1 = softplus_f(r1 + bias), a0 = d0 * A, a1 = d1 * A; float s = a0 + a1;
#pragma unroll
        for (int o = 1; o < 64; o <<= 1) { const float t = __shfl_up(s, o); if (lane >= o) s += t; }
        const float ex = s - (a0 + a1);
        dt_s[w * 128 + j] = d0; dt_s[w * 128 + j + 1] = d1; cs_s[w * 128 + j] = ex + a0; cs_s[w * 128 + j + 1] = ex + a0 + a1; }
}

DI void ssd1_unit(const Params& P, const Frame& F, int unit) {
    const int tid = F.tid, w = F.w, lane = F.lane, l15 = lane & 15, quad = lane >> 4;
    const int g = unit & 3, c = (unit >> 2) & 63, b = unit >> 8;
    const size_t tok0 = (size_t)b * SEQ + c * 128;
    bf16_t* BT = (bf16_t*)F.lds;
    bf16_t* xT = BT + 128 * 136;
    float* dt_s = (float*)(F.lds + 139264);
    float* cs_s = dt_s + 768;
    const bf16_t* src = F_proj + tok0 * NINP + OFF_XBC;
    bf16_t* gx = F_xbcc + tok0 * 2560;
    dtcs_stage(F_dtraw + tok0 * 32 + 6 * g, P.in[I_DTB] + 6 * g, P.in[I_ALOG] + 6 * g, dt_s, cs_s, w, lane);
    conv_stage<128>(src + 1536 + 128 * g, c > 0, P.in[I_CONVW] + 1536 + 128 * g, P.in[I_CONVB] + 1536 + 128 * g, BT, 136, nullptr, nullptr, gx + 1536 + 128 * g, tid);
    conv_stage<128>(src + 2048 + 128 * g, c > 0, P.in[I_CONVW] + 2048 + 128 * g, P.in[I_CONVB] + 2048 + 128 * g, nullptr, 136, nullptr, nullptr, gx + 2048 + 128 * g, tid);
    __syncthreads();
#pragma unroll 1
    for (int hh = 0; hh < 6; ++hh) { const int co = 384 * g + 64 * hh;
        conv_stage<64>(src + co, c > 0, P.in[I_CONVW] + co, P.in[I_CONVB] + co, xT + hh * 64 * 136, 136, dt_s + hh * 128, cs_s + hh * 128, gx + co, tid); }
    __syncthreads();
#pragma unroll 1
    for (int hh = 0; hh < 6; ++hh) {
        const int h = 6 * g + hh;
        f32x4 acc[4];
#pragma unroll
        for (int pt = 0; pt < 4; ++pt) acc[pt] = (f32x4){0.f, 0.f, 0.f, 0.f};
#pragma unroll
        for (int ks = 0; ks < 4; ++ks) { const bf16x8 xb = *(const bf16x8*)(BT + (w * 16 + l15) * 136 + ks * 32 + quad * 8);
#pragma unroll
            for (int pt = 0; pt < 4; ++pt) { const bf16x8 yb = *(const bf16x8*)(xT + (hh * 64 + pt * 16 + l15) * 136 + ks * 32 + quad * 8); acc[pt] = mfma16(xb, yb, acc[pt]); } }
        bf16_t* sp = F_states + ((size_t)(b * 64 + c) * 24 + h) * 8192 + w * 16 + quad * 4;
#pragma unroll
        for (int pt = 0; pt < 4; ++pt) { u32x2 t; t.x = pk2(acc[pt][0], acc[pt][1]); t.y = pk2(acc[pt][2], acc[pt][3]); *(u32x2*)(sp + (pt * 16 + l15) * 128) = t; }
        if (tid == 0) F_cdec[(b * 64 + c) * 24 + h] = __expf(cs_s[hh * 128 + 127]);
    }
    __syncthreads();
}

DI void phase_scan(const Frame& F) {
    const int total = 4 * 24 * 64 * 32, nthreads = F.nblk * 512;
    float* outp = F.out + O_SSMP;
    for (int it = F.blk * 512 + F.tid; it < total; it += nthreads) {
        const int n4 = it & 31, p = (it >> 5) & 63, h = (it >> 11) % 24, b = it / 49152;
        bf16_t* base = F_states + ((size_t)(b * 64) * 24 + h) * 8192 + p * 128 + n4 * 4;
        const float* dcp = F_cdec + (b * 64) * 24 + h;
        f32x4 run = (f32x4){0.f, 0.f, 0.f, 0.f};
        for (int c0 = 0; c0 < 64; c0 += 8) {
            u32x2 sv[8]; float dc[8];
#pragma unroll
            for (int k = 0; k < 8; ++k) { sv[k] = *(const u32x2*)(base + (size_t)(c0 + k) * 24 * 8192); dc[k] = dcp[(c0 + k) * 24]; }
#pragma unroll
            for (int k = 0; k < 8; ++k) { u32x2 pv; pv.x = pk2(run[0], run[1]); pv.y = pk2(run[2], run[3]); *(u32x2*)(base + (size_t)(c0 + k) * 24 * 8192) = pv;
                run[0] = run[0] * dc[k] + bflo(sv[k].x); run[1] = run[1] * dc[k] + bfhi(sv[k].x); run[2] = run[2] * dc[k] + bflo(sv[k].y); run[3] = run[3] * dc[k] + bfhi(sv[k].y); }
        }
        *(f32x4*)(outp + ((size_t)(b * 24 + h) * 64 + p) * 128 + n4 * 4) = run;
    }
}

DI void ssd3_unit(const Params& P, const Frame& F, int unit) {
    const int tid = F.tid, w = F.w, lane = F.lane, l15 = lane & 15, quad = lane >> 4;
    const int g = unit & 3, c = (unit >> 2) & 63, b = unit >> 8;
    const size_t tok0 = (size_t)b * SEQ + c * 128;
    bf16_t* Bs = (bf16_t*)F.lds;
    bf16_t* xs = Bs + 128 * 136;
    float* dt_s = (float*)(F.lds + 139264);
    float* cs_s = dt_s + 768;
    float* nw_s = cs_s + 768;
    const bf16_t* gx = F_xbcc + tok0 * 2560;
    dtcs_stage(F_dtraw + tok0 * 32 + 6 * g, P.in[I_DTB] + 6 * g, P.in[I_ALOG] + 6 * g, dt_s, cs_s, w, lane);
    if (tid < 96) *(f32x4*)(nw_s + tid * 4) = *(const f32x4*)(P.in[I_NORMW] + 384 * g + tid * 4);
#pragma unroll
    for (int k = 0; k < 4; ++k) { const int idx = tid + 512 * k, row = idx >> 4, ch = idx & 15;
        *(u32x4*)(Bs + row * 136 + ch * 8) = *(const u32x4*)(gx + (size_t)row * 2560 + 1536 + 128 * g + ch * 8); }
#pragma unroll 4
    for (int k = 0; k < 12; ++k) { const int idx = tid + 512 * k, row = idx / 48, ch = idx % 48;
        *(u32x4*)(xs + row * 400 + ch * 8) = *(const u32x4*)(gx + (size_t)row * 2560 + 384 * g + ch * 8); }
    const int i = w * 16 + l15;
    bf16x8 Cf[4];
#pragma unroll
    for (int ks = 0; ks < 4; ++ks) Cf[ks] = *(const bf16x8*)(gx + (size_t)i * 2560 + 2048 + 128 * g + ks * 32 + quad * 8);
    __syncthreads();
    f32x4 gt[8];
#pragma unroll
    for (int jt = 0; jt < 8; ++jt) { gt[jt] = (f32x4){0.f, 0.f, 0.f, 0.f};
        if (jt <= w) {
#pragma unroll
            for (int ks = 0; ks < 4; ++ks) { const bf16x8 xb = *(const bf16x8*)(Bs + (jt * 16 + l15) * 136 + ks * 32 + quad * 8); gt[jt] = mfma16(xb, Cf[ks], gt[jt]); } } }
    float ss = 0.f;
    const size_t orow = (tok0 + i) * NINP;
    const unsigned xbase = (unsigned)(size_t)xs + (unsigned)((quad * 4 + (l15 >> 2)) * 800 + (l15 & 3) * 8);
#pragma unroll 1
    for (int hh = 0; hh < 6; ++hh) {
        const int h = 6 * g + hh, h3 = hh;
        const float csi = cs_s[hh * 128 + i];
        u32x2 zv4[4];
#pragma unroll
        for (int pt = 0; pt < 4; ++pt) zv4[pt] = *(const u32x2*)(F_proj + orow + OFF_Z + 384 * g + hh * 64 + pt * 16 + quad * 4);
        f32x4 ya[4], off[4];
#pragma unroll
        for (int pt = 0; pt < 4; ++pt) { ya[pt] = (f32x4){0.f, 0.f, 0.f, 0.f}; off[pt] = (f32x4){0.f, 0.f, 0.f, 0.f}; }
#pragma unroll
        for (int sg = 0; sg < 4; ++sg) {
            if (2 * sg <= w) {
                float pv[8];
#pragma unroll
                for (int q = 0; q < 2; ++q) { const int jt = 2 * sg + q, jb = jt * 16 + quad * 4;
                    const f32x4 csj = *(const f32x4*)(cs_s + hh * 128 + jb), dtj = *(const f32x4*)(dt_s + hh * 128 + jb);
#pragma unroll
                    for (int jj = 0; jj < 4; ++jj) { const int j = jb + jj; const float e = __expf(fminf(csi - csj[jj], 0.f)) * dtj[jj]; pv[q * 4 + jj] = (j <= i) ? gt[jt][jj] * e : 0.f; } }
                u32x4 pw; pw.x = pk2(pv[0], pv[1]); pw.y = pk2(pv[2], pv[3]); pw.z = pk2(pv[4], pv[5]); pw.w = pk2(pv[6], pv[7]);
                const bf16x8 pf = __builtin_bit_cast(bf16x8, pw);
                s16x4 lo[4], hi[4];
                tr8<800>(xbase + (unsigned)(sg * 32 * 800 + h3 * 128), lo, hi);
#pragma unroll
                for (int pt = 0; pt < 4; ++pt) { const bf16x8 xf = __builtin_shufflevector(lo[pt], hi[pt], 0, 1, 2, 3, 4, 5, 6, 7); ya[pt] = mfma16(xf, pf, ya[pt]); }
            }
        }
        const bf16_t* pr = F_states + ((size_t)(b * 64 + c) * 24 + h) * 8192;
#pragma unroll
        for (int pt = 0; pt < 4; ++pt)
#pragma unroll
            for (int ks = 0; ks < 4; ++ks) { const bf16x8 xb = *(const bf16x8*)(pr + (pt * 16 + l15) * 128 + ks * 32 + quad * 8); off[pt] = mfma16(xb, Cf[ks], off[pt]); }
        const float ecs = __expf(csi), Dh = P.in[I_DSKIP][h];
#pragma unroll
        for (int pt = 0; pt < 4; ++pt) { const int p0 = pt * 16 + quad * 4;
            const u32x2 zv = zv4[pt];
            const float z[4] = {bflo(zv.x), bfhi(zv.x), bflo(zv.y), bfhi(zv.y)};
            float yv[4]; const u32x2 xr2 = *(const u32x2*)(xs + i * 400 + h3 * 64 + p0); const float xv4[4] = {bflo(xr2.x), bfhi(xr2.x), bflo(xr2.y), bfhi(xr2.y)};
#pragma unroll
            for (int jj = 0; jj < 4; ++jj) { yv[jj] = (ya[pt][jj] + off[pt][jj] * ecs + Dh * xv4[jj]) * silu_f(z[jj]); ss += yv[jj] * yv[jj]; }
            u32x2 t; t.x = pk2(yv[0], yv[1]); t.y = pk2(yv[2], yv[3]);
            *(u32x2*)(F_proj + orow + 512 + 384 * g + hh * 64 + p0) = t; }
    }
    ss += __shfl_xor(ss, 16); ss += __shfl_xor(ss, 32);
    const float rn = rsqrtf(ss * (1.f / 384.f) + EPS);
    u32x2 yb[6][4];
#pragma unroll
    for (int hh = 0; hh < 6; ++hh)
#pragma unroll
        for (int pt = 0; pt < 4; ++pt) yb[hh][pt] = *(const u32x2*)(F_proj + orow + 512 + 384 * g + hh * 64 + pt * 16 + quad * 4);
#pragma unroll
    for (int hh = 0; hh < 6; ++hh)
#pragma unroll
        for (int pt = 0; pt < 4; ++pt) { const int cc = hh * 64 + pt * 16 + quad * 4; const f32x4 wv = *(const f32x4*)(nw_s + cc); const u32x2 yv = yb[hh][pt];
            u32x2 t; t.x = pk2(bflo(yv.x) * rn * wv[0], bfhi(yv.x) * rn * wv[1]); t.y = pk2(bflo(yv.y) * rn * wv[2], bfhi(yv.y) * rn * wv[3]);
            *(u32x2*)(F_proj + orow + 512 + 384 * g + cc) = t; }
    __syncthreads();
}

DI void sample_ssd_item(const Params& P, const Frame& F, int item) {
    const int tid = F.tid, w = F.w, lane = F.lane;
    const int b = item >> 2, g = item & 3;
    float* xs = (float*)F.lds;
    float* Bs = xs + 1536;
    float* Cs = Bs + 512;
    float* dts = Cs + 512;
    float* yg = dts + 32;
    const size_t row0 = (size_t)MP + 4 * b;
    for (int idx = tid; idx < 640; idx += 512) {
        const int col = idx < 384 ? 384 * g + idx : (idx < 512 ? 1536 + 128 * g + (idx - 384) : 2048 + 128 * g + (idx - 512));
        float xp[7];
#pragma unroll
        for (int k = 0; k < 3; ++k) xp[k] = P.in[I_SCONV][((size_t)b * 3 + k) * 2560 + col];
#pragma unroll
        for (int l = 0; l < 4; ++l) xp[3 + l] = bf2f(F_proj[(row0 + l) * NINP + OFF_XBC + col]);
        const float w0 = P.in[I_CONVW][col], w1 = P.in[I_CONVW][2560 + col], w2 = P.in[I_CONVW][5120 + col], w3 = P.in[I_CONVW][7680 + col], bs = P.in[I_CONVB][col];
#pragma unroll
        for (int l = 0; l < 4; ++l) { const float y = silu_f(bs + w0 * xp[l] + w1 * xp[l + 1] + w2 * xp[l + 2] + w3 * xp[l + 3]);
            if (idx < 384) xs[l * 384 + idx] = y; else if (idx < 512) Bs[l * 128 + idx - 384] = y; else Cs[l * 128 + idx - 512] = y; }
    }
    if (tid < 24) { const int l = tid / 6, hh = tid % 6; dts[l * 8 + hh] = softplus_f(F_dtraw[(row0 + l) * 32 + 6 * g + hh] + P.in[I_DTB][6 * g + hh]); }
    __syncthreads();
    const int p = tid >> 3, nq = tid & 7;
#pragma unroll 1
    for (int hh = 0; hh < 6; ++hh) {
        const int h = 6 * g + hh; const float A = -__expf(P.in[I_ALOG][h]), Dh = P.in[I_DSKIP][h];
        const size_t so = ((size_t)(b * 24 + h) * 64 + p) * 128 + nq * 16;
        f32x4 s[4];
#pragma unroll
        for (int q = 0; q < 4; ++q) s[q] = *(const f32x4*)(P.in[I_SSSM] + so + 4 * q);
#pragma unroll
        for (int l = 0; l < 4; ++l) { const float dt = dts[l * 8 + hh], dA = __expf(dt * A), xv = xs[l * 384 + hh * 64 + p], dx = dt * xv; float yp = 0.f;
#pragma unroll
            for (int q = 0; q < 4; ++q) { const f32x4 Bv = *(const f32x4*)(Bs + l * 128 + nq * 16 + 4 * q), Cv = *(const f32x4*)(Cs + l * 128 + nq * 16 + 4 * q);
                s[q] = s[q] * dA + Bv * dx; yp += (Cv[0] * s[q][0] + Cv[1] * s[q][1]) + (Cv[2] * s[q][2] + Cv[3] * s[q][3]); }
            yp += __shfl_xor(yp, 1); yp += __shfl_xor(yp, 2); yp += __shfl_xor(yp, 4);
            if (nq == 0) { const float z = bf2f(F_proj[(row0 + l) * NINP + OFF_Z + 384 * g + hh * 64 + p]); yg[l * 384 + hh * 64 + p] = (yp + Dh * xv) * silu_f(z); } }
#pragma unroll
        for (int q = 0; q < 4; ++q) *(f32x4*)(F.out + O_SSMS + so + 4 * q) = s[q];
    }
    __syncthreads();
    if (w < 4) { const int l = w; float v[6]; float ss = 0.f;
#pragma unroll
        for (int k = 0; k < 6; ++k) { v[k] = yg[l * 384 + lane + 64 * k]; ss += v[k] * v[k]; }
        ss = wave_sum(ss); const float rn = rsqrtf(ss * (1.f / 384.f) + EPS);
#pragma unroll
        for (int k = 0; k < 6; ++k) { const int col = lane + 64 * k; F_proj[(row0 + l) * NINP + 512 + 384 * g + col] = f2bf(v[k] * rn * P.in[I_NORMW][384 * g + col]); } }
    __syncthreads();
}

DI void sample_attn_item(const Params& P, const Frame& F, int item) {
    const int tid = F.tid, w = F.w, lane = F.lane;
    const int b = item >> 3, h = item & 7;
    float* qs = (float*)F.lds + w * 256;
    float* ps = qs + 64;
    float* ores = (float*)F.lds + 8 * 256;
    float* lres = ores + 12 * 64;
    const size_t row0 = (size_t)MP + 4 * b;
#pragma unroll 1
    for (int rnd = 0; rnd < 2; ++rnd) {
        const int task = w + 8 * rnd;
        if (task < 12) {
            const int g = task >> 2, l = task & 3;
            const int W = g == 0 ? 128 : (g == 1 ? 512 : 2048), d = g == 0 ? 1 : (g == 1 ? 4 : 16);
            const float* cache = (g == 0 ? P.in[I_C128] : (g == 1 ? P.in[I_C512] : P.in[I_C2048]));
            const int qc = g * 1536 + h * 64;
            qs[lane] = bf2f(F_proj[(row0 + l) * NINP + qc + lane]) * 0.125f;
            asm volatile("s_waitcnt lgkmcnt(0)" ::: "memory");
            float sc[3];
#pragma unroll
            for (int r3 = 0; r3 < 3; ++r3) { const int j = lane + 64 * r3; float dot = -INFINITY;
                if (j <= 128) { const int idx = W + l - d * j; dot = 0.f;
                    if (idx >= W) { const bf16_t* kp = F_proj + (row0 + (idx - W)) * NINP + qc + 512;
#pragma unroll
                        for (int e8 = 0; e8 < 8; ++e8) { float kf[8]; unpack8(*(const u32x4*)(kp + e8 * 8), kf);
#pragma unroll
                            for (int e = 0; e < 8; ++e) dot += kf[e] * qs[e8 * 8 + e]; }
                    } else { const float* kp = cache + (((size_t)b * W + idx) * 2 * 8 + h) * 64;
#pragma unroll
                        for (int e4 = 0; e4 < 16; ++e4) { const f32x4 kk = *(const f32x4*)(kp + e4 * 4); const f32x4 qq = *(const f32x4*)(qs + e4 * 4);
                            dot += (kk[0] * qq[0] + kk[1] * qq[1]) + (kk[2] * qq[2] + kk[3] * qq[3]); } } }
                sc[r3] = dot; }
            const float m = wave_max(fmaxf(fmaxf(sc[0], sc[1]), sc[2]));
            float dsum = 0.f;
#pragma unroll
            for (int r3 = 0; r3 < 3; ++r3) { const float p = __expf(sc[r3] - m); dsum += p; ps[lane + 64 * r3] = p; }
            const float den = wave_sum(dsum);
            asm volatile("s_waitcnt lgkmcnt(0)" ::: "memory");
            const int e4 = lane & 15, sub = lane >> 4;
            f32x4 acc = (f32x4){0.f, 0.f, 0.f, 0.f};
#pragma unroll 11
            for (int j = sub; j <= 128; j += 4) { const int idx = W + l - d * j; const float p = ps[j]; f32x4 vv;
                if (idx >= W) { const u32x2 t = *(const u32x2*)(F_proj + (row0 + (idx - W)) * NINP + qc + 1024 + e4 * 4); vv[0] = bflo(t.x); vv[1] = bfhi(t.x); vv[2] = bflo(t.y); vv[3] = bfhi(t.y); }
                else vv = *(const f32x4*)(cache + ((((size_t)b * W + idx) * 2 + 1) * 8 + h) * 64 + e4 * 4);
                acc += vv * p; }
#pragma unroll
            for (int q = 0; q < 4; ++q) { acc[q] += __shfl_xor(acc[q], 16); acc[q] += __shfl_xor(acc[q], 32); }
            if (sub == 0) *(f32x4*)(ores + task * 64 + e4 * 4) = acc * (1.f / den);
            if (lane == 0) lres[task] = m + __logf(den);
            { const int kv = lane >> 5, e2 = (lane & 31) * 2; const unsigned t = *(const unsigned*)(F_proj + (row0 + l) * NINP + qc + 512 + kv * 512 + e2);
              float* dp = F_newkv + ((((size_t)(4 * b + l) * 3 + g) * 2 + kv) * 8 + h) * 64 + e2; dp[0] = bflo(t); dp[1] = bfhi(t); }
        }
    }
    __syncthreads();
    if (tid < 256) { const int l = tid >> 6, e = tid & 63;
        const float l0 = lres[l], l1 = lres[4 + l], l2 = lres[8 + l], mm = fmaxf(fmaxf(l0, l1), l2);
        const float a0 = __expf(l0 - mm), a1 = __expf(l1 - mm), a2 = __expf(l2 - mm), inv = 1.f / (a0 + a1 + a2);
        const float o = (a0 * ores[l * 64 + e] + a1 * ores[(4 + l) * 64 + e] + a2 * ores[(8 + l) * 64 + e]) * inv;
        F_proj[(row0 + l) * NINP + h * 64 + e] = f2bf(o); }
    __syncthreads();
}

DI void copy_row_bf16_f32(const bf16_t* src, float* dst, int n512, int lane) {
    for (int jj = 0; jj < n512; ++jj) { const int e0 = lane * 8 + 512 * jj; float f[8]; unpack8(*(const u32x4*)(src + e0), f);
        *(f32x4*)(dst + e0) = (f32x4){f[0], f[1], f[2], f[3]}; *(f32x4*)(dst + e0 + 4) = (f32x4){f[4], f[5], f[6], f[7]}; }
}
DI void phase5_copies(const Frame& F) {
    const int gw = F.blk * 8 + F.w, NGW = F.nblk * 8;
    for (int rr = gw; rr < 10752 + 12 + 96; rr += NGW) {
        if (rr < 10752) { int q = rr, g, W; size_t ob;
            if (q < 512) { g = 0; W = 128; ob = O_KV128P; } else if (q < 2560) { q -= 512; g = 1; W = 512; ob = O_KV512P; } else { q -= 2560; g = 2; W = 2048; ob = O_KV2048P; }
            const int b = q / W, i = q % W;
            copy_row_bf16_f32(F_proj + ((size_t)b * SEQ + SEQ - W + i) * NINP + g * 1536 + 512, F.out + ob + ((size_t)b * W + i) * 1024, 2, F.lane);
        } else if (rr < 10764) { const int q = rr - 10752, b = q / 3, i = q % 3;
            copy_row_bf16_f32(F_proj + ((size_t)b * SEQ + SEQ - 3 + i) * NINP + OFF_XBC, F.out + O_CONVP + (size_t)q * 2560, 5, F.lane);
        } else { const int q = rr - 10764, b = q / 3, i = q % 3;
            copy_row_bf16_f32(F_proj + ((size_t)MP + 4 * b + 1 + i) * NINP + OFF_XBC, F.out + O_CONVS + (size_t)q * 2560, 5, F.lane); }
    }
}
DI void phase7_combine(const Frame& F) {
    const int gw = F.blk * 8 + F.w, NGW = F.nblk * 8, lane = F.lane, h = lane >> 3;
    for (int row0 = gw; row0 < MP; row0 += 4 * NGW) {
        float l[4][3]; u32x4 v[4][3];
#pragma unroll
        for (int r = 0; r < 4; ++r) { const int row = row0 + r * NGW; if (row < MP) {
            const float* lp = F_lse + (size_t)row * 24 + h; l[r][0] = lp[0]; l[r][1] = lp[8]; l[r][2] = lp[16];
            const bf16_t* op = F_atto + (size_t)row * 1536 + lane * 8; v[r][0] = *(const u32x4*)op; v[r][1] = *(const u32x4*)(op + 512); v[r][2] = *(const u32x4*)(op + 1024); } }
#pragma unroll
        for (int r = 0; r < 4; ++r) { const int row = row0 + r * NGW; if (row < MP) {
            const float mm = fmaxf(fmaxf(l[r][0], l[r][1]), l[r][2]);
            const float a0 = __expf(l[r][0] - mm), a1 = __expf(l[r][1] - mm), a2 = __expf(l[r][2] - mm), inv = 1.f / (a0 + a1 + a2);
            float f0[8], f1[8], f2[8], o[8]; unpack8(v[r][0], f0); unpack8(v[r][1], f1); unpack8(v[r][2], f2);
#pragma unroll
            for (int e = 0; e < 8; ++e) o[e] = (a0 * f0[e] + a1 * f1[e] + a2 * f2[e]) * inv;
            u32x4 t; t.x = pk2(o[0], o[1]); t.y = pk2(o[2], o[3]); t.z = pk2(o[4], o[5]); t.w = pk2(o[6], o[7]);
            *(u32x4*)(F_proj + (size_t)row * NINP + lane * 8) = t; } }
    }
}
template <int G> DI void kvcopy_range(const float* __restrict__ cache, float* __restrict__ outp, size_t q_lo, size_t q_hi, int rank, int nranks, int tid) {
    constexpr int W = G == 0 ? 128 : (G == 1 ? 512 : 2048);
    const size_t nthreads = (size_t)nranks * 512;
    for (size_t q0 = q_lo + (size_t)rank * 512 + tid; q0 < q_hi; q0 += 4 * nthreads) {
        f32x4 v[4];
#pragma unroll
        for (int k = 0; k < 4; ++k) { const size_t q = q0 + k * nthreads; if (q < q_hi) {
            const int row = (int)(q >> 8), c4 = (int)(q & 255), b = row / W, i = row % W;
            if (i + 4 < W) v[k] = *(const f32x4*)(cache + ((size_t)b * W + i + 4) * 1024 + c4 * 4); } }
#pragma unroll
        for (int k = 0; k < 4; ++k) { const size_t q = q0 + k * nthreads; if (q < q_hi) { const int i = (int)(q >> 8) % W; if (i + 4 < W) *(f32x4*)(outp + q * 4) = v[k]; } }
    }
}
template <int G> DI void kvcopy_new(const float* __restrict__ newkv, float* __restrict__ outp, int blk, int nblk, int tid) {
    constexpr int W = G == 0 ? 128 : (G == 1 ? 512 : 2048);
    for (int q = blk * 512 + tid; q < 32 * 4 * 256; q += nblk * 512) { const int c4 = q & 255, l = (q >> 8) & 3, b = q >> 10;
        *(f32x4*)(outp + ((size_t)b * W + W - 4 + l) * 1024 + c4 * 4) = *(const f32x4*)(newkv + ((size_t)(4 * b + l) * 3 + G) * 1024 + c4 * 4); }
}
constexpr size_t KV2_TOTAL = (size_t)32 * 2048 * 256, KV2_A = (KV2_TOTAL * 27 / 100) & ~(size_t)255, KV2_B = (KV2_TOTAL * 54 / 100) & ~(size_t)255;
template <int WHICH> DI void kv_filler(const Params& P, const Frame& F, int ntail) {
    if (F.blk < ntail || F.nblk <= ntail) return;
    const int rank = F.blk - ntail, nranks = F.nblk - ntail;
    if (WHICH == 0) kvcopy_range<1>(P.in[I_C512], F.out + O_KV512S, 0, (size_t)32 * 512 * 256, rank, nranks, F.tid);
    if (WHICH == 1) kvcopy_range<0>(P.in[I_C128], F.out + O_KV128S, 0, (size_t)32 * 128 * 256, rank, nranks, F.tid);
    if (WHICH == 2) kvcopy_range<2>(P.in[I_C2048], F.out + O_KV2048S, 0, KV2_A, rank, nranks, F.tid);
    if (WHICH == 3) kvcopy_range<2>(P.in[I_C2048], F.out + O_KV2048S, KV2_A, KV2_B, rank, nranks, F.tid);
}
DI void phase_kvcopy(const Params& P, const Frame& F) {
    if (F.nblk <= 22) {
        kvcopy_range<1>(P.in[I_C512], F.out + O_KV512S, 0, (size_t)32 * 512 * 256, F.blk, F.nblk, F.tid);
        kvcopy_range<0>(P.in[I_C128], F.out + O_KV128S, 0, (size_t)32 * 128 * 256, F.blk, F.nblk, F.tid);
        kvcopy_range<2>(P.in[I_C2048], F.out + O_KV2048S, 0, KV2_B, F.blk, F.nblk, F.tid); }
    kvcopy_range<2>(P.in[I_C2048], F.out + O_KV2048S, KV2_B, KV2_TOTAL, F.blk, F.nblk, F.tid);
    kvcopy_new<0>(F_newkv, F.out + O_KV128S, F.blk, F.nblk, F.tid);
    kvcopy_new<1>(F_newkv, F.out + O_KV512S, F.blk, F.nblk, F.tid);
    kvcopy_new<2>(F_newkv, F.out + O_KV2048S, F.blk, F.nblk, F.tid);
}

__global__ void __launch_bounds__(512, 2) fwd_megakernel(Params P) {
    extern __shared__ __attribute__((aligned(16))) unsigned char shm[];
    cg::grid_group grid = cg::this_grid();
    Frame F; F.out = P.out; F.ws = P.ws; F.lds = shm; F.tid = threadIdx.x; F.lane = threadIdx.x & 63; F.w = __builtin_amdgcn_readfirstlane(threadIdx.x >> 6); F.nblk = gridDim.x; F.blk = blockIdx.x;

    volatile LAS unsigned* bst = (volatile LAS unsigned*)(LAS unsigned char*)(shm + LDS_BAR_OFF);
    if (threadIdx.x < 2) bst[threadIdx.x] = 0u;
    __syncthreads();
    const XcdBarrier XB = xcd_barrier_post((unsigned*)(P.ws + WS_BAR), bst);
#define GSYNC(k) do { if ((k) == 0) { asm volatile("s_waitcnt vmcnt(0)" ::: "memory"); grid.sync(); } else xcd_barrier(XB); } while (0)
#define PHASE(k, body) do { if ((PHASE_MASK & (1 << (k))) && P.ph_lo <= (k) && (k) < P.ph_hi) { body if (DOUBLE_MASK & (1 << (k))) { GSYNC(1); body } } if (P.ph_lo <= (k) && (k) + 1 < P.ph_hi) GSYNC(k); } while (0)
    PHASE(0, phase_prep(P, F););
    PHASE(1, { zero_f_sample(F); EpiSwiglu E; E.O = F_act; run_gemm(F, F_xn, 1024, F_wgu1, 5632, 1024, E); kv_filler<0>(P, F, 22); });
    PHASE(2, { EpiF32 E; E.C = F_f; run_gemm(F, F_act, FF, F_wd1, 1024, FF, E, 4); });
    PHASE(3, phase_rows<0>(P, F););
    PHASE(4, { EpiProj E; E.O = F_proj; E.dtraw = F_dtraw; run_gemm(F, F_xn, 1024, F_win, NINP, 1024, E); });
    PHASE(5, {
        if (SUB_MASK & 1) phase_attn(F, (DOUBLE_SUB & 1) ? 2 : 1);
        if (SUB_MASK & 2) for (int rep = 0; rep < ((DOUBLE_SUB & 2) ? 2 : 1); ++rep) for (int u = F.blk; u < 1024; u += F.nblk) ssd1_unit(P, F, u);
        if (SUB_MASK & 4) for (int u = F.blk; u < 256; u += F.nblk) sample_attn_item(P, F, u);
        if (SUB_MASK & 8) phase5_copies(F); });
    PHASE(6, { phase_scan(F); if (SUB_MASK & 32) for (int u = (F.blk + F.nblk / 2) % F.nblk; u < 128; u += F.nblk) sample_ssd_item(P, F, u); });
    PHASE(7, {
        if (SUB_MASK & 16) for (int rep = 0; rep < ((DOUBLE_SUB & 16) ? 2 : 1); ++rep) for (int u = F.blk; u < 1024; u += F.nblk) ssd3_unit(P, F, u);
        if (SUB_MASK & 64) for (int rep = 0; rep < ((DOUBLE_SUB & 64) ? 2 : 1); ++rep) phase7_combine(F); });
    PHASE(8, { EpiGate<0> E; E.proj = F_proj; E.m1 = F_m1; E.merged = F_xn; run_gemm(F, F_proj, NINP, F_wa, 1024, 512, E); });
    PHASE(9, { EpiGate<1> E; E.proj = F_proj; E.m1 = F_m1; E.merged = F_xn; run_gemm(F, F_proj + 512, NINP, F_wb, 1024, 1536, E); kv_filler<1>(P, F, 4); });
    PHASE(10, { EpiF32 E; E.C = F_f; run_gemm(F, F_xn, 1024, F_wo, 1024, 1024, E); kv_filler<2>(P, F, 4); });
    PHASE(11, phase_rows<1>(P, F););
    PHASE(12, { zero_f_sample(F); EpiSwiglu E; E.O = F_act; run_gemm(F, F_xn, 1024, F_wgu2, 5632, 1024, E); kv_filler<3>(P, F, 22); });
    PHASE(13, { EpiF32 E; E.C = F_f; run_gemm(F, F_act, FF, F_wd2, 1024, FF, E, 4); });
    PHASE(14, { phase_rows<2>(P, F); phase_kvcopy(P, F); });
}

extern "C" void kernel_launch(void* const* d_in, const int* in_sizes, int n_in, void* d_out, int out_size, void* d_ws, size_t ws_size, hipStream_t stream) {
    static int grid_blocks = 0;
    if (grid_blocks == 0) {
        if (n_in != 29 || (size_t)out_size != O_TOTAL || ws_size < WS_END) { fprintf(stderr, "kernel_launch: unexpected shapes: n_in %d out %d ws %zu (need %zu)\n", n_in, out_size, ws_size, (size_t)WS_END); grid_blocks = -1; return; }
        int dev = 0, cus = 0, per_cu = 0;
        hipGetDevice(&dev); hipDeviceGetAttribute(&cus, hipDeviceAttributeMultiprocessorCount, dev);
        if (hipFuncSetAttribute((const void*)fwd_megakernel, hipFuncAttributeMaxDynamicSharedMemorySize, LDS_BYTES) != hipSuccess) { fprintf(stderr, "kernel_launch: hipFuncSetAttribute failed\n"); grid_blocks = -1; return; }
        hipOccupancyMaxActiveBlocksPerMultiprocessor(&per_cu, (const void*)fwd_megakernel, 512, LDS_BYTES);
        if (per_cu < 1) { fprintf(stderr, "kernel_launch: occupancy query says %d blocks per CU\n", per_cu); grid_blocks = -1; return; }
        grid_blocks = cus;
    }
    if (grid_blocks < 0) return;
    if (hipMemsetAsync((char*)d_ws + WS_BAR, 0, 16384, stream) != hipSuccess) { fprintf(stderr, "kernel_launch: memset failed\n"); return; }
    Params p{};
    for (int i = 0; i < 29; ++i) p.in[i] = (const float*)d_in[i];
    p.out = (float*)d_out; p.ws = (unsigned char*)d_ws;
#if N_LAUNCH_PER_PHASE
    for (int ph = 0; ph < NPHASE; ++ph) { p.ph_lo = ph; p.ph_hi = ph + 1; void* args[] = {&p};
        hipLaunchCooperativeKernel((void*)fwd_megakernel, dim3(grid_blocks), dim3(512), args, LDS_BYTES, stream); }
#else
    p.ph_lo = 0; p.ph_hi = NPHASE; void* args[] = {&p};
    hipError_t e = hipLaunchCooperativeKernel((void*)fwd_megakernel, dim3(grid_blocks), dim3(512), args, LDS_BYTES, stream);
    if (e != hipSuccess) fprintf(stderr, "cooperative launch failed: %s (grid %d)\n", hipGetErrorString(e), grid_blocks);
#endif
}
```

```cpp
#include <hip/hip_runtime.h>
#include <hip/hip_cooperative_groups.h>
#include <cstdio>
namespace cg = cooperative_groups;

#define DI __device__ __forceinline__
#define LAS __attribute__((address_space(3)))
typedef unsigned short bf16_t;
typedef short bf16x8 __attribute__((ext_vector_type(8)));
typedef short s16x4 __attribute__((ext_vector_type(4)));
typedef float f32x4 __attribute__((ext_vector_type(4)));
typedef unsigned u32x4 __attribute__((ext_vector_type(4)));
typedef unsigned u32x2 __attribute__((ext_vector_type(2)));

#ifndef SUB_MASK
#define SUB_MASK 0xff
#endif
#ifndef DOUBLE_SUB
#define DOUBLE_SUB 0
#endif
#ifndef DOUBLE_MASK
#define DOUBLE_MASK 0
#endif
#ifndef PHASE_MASK
#define PHASE_MASK 0x7fff
#endif
#ifndef N_LAUNCH_PER_PHASE
#define N_LAUNCH_PER_PHASE 0
#endif

constexpr int D = 1024, SEQ = 8192, MP = 32768, MS = 128, MROWS = MP + MS, MT = 33024;
constexpr int FF = 2816, NIN = 10776, NINP = 11008;
constexpr int OFF_Z = 4608, OFF_XBC = 6144, OFF_DT = 8704, OFF_GATE = 8728;
constexpr int LDS_BAR_OFF = 147456, LDS_BYTES = LDS_BAR_OFF + 16, NPHASE = 15;
constexpr float EPS = 1e-6f;

enum { I_XP = 0, I_XS, I_C128, I_C512, I_C2048, I_SCONV, I_SSSM, I_WIN, I_CONVW, I_CONVB, I_DTB, I_ALOG, I_DSKIP, I_NORMW, I_WA, I_WB, I_WO,
       I_G1, I_U1, I_D1, I_G2, I_U2, I_D2, I_GPRE1, I_GPOST1, I_GPREM, I_GPOSTM, I_GPRE2, I_GPOST2 };
constexpr size_t O_YP = 0, O_YS = 33554432, O_KV128P = 33685504, O_KV512P = 34209792, O_KV2048P = 36306944, O_CONVP = 44695552, O_SSMP = 44726272,
                 O_KV128S = 45512704, O_KV512S = 49707008, O_KV2048S = 66484224, O_CONVS = 133593088, O_SSMS = 133838848, O_TOTAL = 140130304;
constexpr size_t SZ_WGU = (size_t)5632 * 1024 * 2, SZ_WD = (size_t)1024 * 2816 * 2;
constexpr size_t WS_WGU1 = 0, WS_WD1 = WS_WGU1 + SZ_WGU, WS_WGU2 = WS_WD1 + SZ_WD, WS_WD2 = WS_WGU2 + SZ_WGU, WS_WIN = WS_WD2 + SZ_WD,
                 WS_WA = WS_WIN + (size_t)NINP * 1024 * 2, WS_WB = WS_WA + (size_t)1024 * 512 * 2, WS_WO = WS_WB + (size_t)1024 * 1536 * 2,
                 WS_XN = WS_WO + (size_t)1024 * 1024 * 2, WS_DTRAW = WS_XN + (size_t)MT * 1024 * 2, WS_NEWKV = WS_DTRAW + (size_t)MT * 32 * 4,
                 WS_CDEC = WS_NEWKV + (size_t)128 * 3 * 1024 * 4, WS_BAR = WS_CDEC + (size_t)4 * 64 * 24 * 4, WS_PROJ = WS_BAR + 16384,
                 WS_XBCC = WS_PROJ + (size_t)MT * NINP * 2, WS_END = WS_XBCC + (size_t)MP * 2560 * 2;
constexpr size_t WS_ACT = WS_PROJ, WS_F = WS_PROJ + 268435456;
constexpr size_t SC_ATTO = 0, SC_LSE = SC_ATTO + (size_t)MT * 1536 * 2, SC_STATES = SC_LSE + (size_t)MT * 24 * 4, SC_END = SC_STATES + (size_t)4 * 64 * 24 * 8192 * 2;
constexpr size_t SC_M1 = 0;
static_assert(SC_END <= (size_t)67108864 * 4, "scratch too big");
static_assert((size_t)MT * 1024 * 4 <= (size_t)67108864 * 4, "m1 too big");

struct Params { const float* in[29]; float* out; unsigned char* ws; int ph_lo, ph_hi; };

typedef __bf16 bf16x2_t __attribute__((ext_vector_type(2)));
typedef float f32x2_t __attribute__((ext_vector_type(2)));
DI unsigned pk2(float lo, float hi) { const f32x2_t v = {lo, hi}; const bf16x2_t b = __builtin_convertvector(v, bf16x2_t); return __builtin_bit_cast(unsigned, b); }
DI bf16_t f2bf(float x) { return (bf16_t)(pk2(x, 0.f) & 0xffffu); }
DI float bflo(unsigned u) { return __uint_as_float(u << 16); }
DI float bfhi(unsigned u) { return __uint_as_float(u & 0xffff0000u); }
DI float bf2f(bf16_t b) { return __uint_as_float(((unsigned)b) << 16); }
DI float wave_sum(float v) {
#pragma unroll
    for (int o = 1; o < 64; o <<= 1) v += __shfl_xor(v, o);
    return v; }
DI float wave_max(float v) {
#pragma unroll
    for (int o = 1; o < 64; o <<= 1) v = fmaxf(v, __shfl_xor(v, o));
    return v; }
DI float silu_f(float x) { return x * __builtin_amdgcn_rcpf(1.f + __expf(-x)); }
DI float sigmoid_f(float x) { return __builtin_amdgcn_rcpf(1.f + __expf(-x)); }
DI float softplus_f(float x) { return x > 20.f ? x : log1pf(__expf(x)); }
DI void lds_barrier() { asm volatile("s_waitcnt lgkmcnt(0)" ::: "memory"); __builtin_amdgcn_s_barrier(); asm volatile("" ::: "memory"); }
template <int ROWB> DI void tr8(unsigned addr, s16x4 (&a)[4], s16x4 (&b)[4]) {
    asm volatile("ds_read_b64_tr_b16 %0, %8\n\tds_read_b64_tr_b16 %1, %8 offset:%9\n\t"
                 "ds_read_b64_tr_b16 %2, %8 offset:32\n\tds_read_b64_tr_b16 %3, %8 offset:%10\n\t"
                 "ds_read_b64_tr_b16 %4, %8 offset:64\n\tds_read_b64_tr_b16 %5, %8 offset:%11\n\t"
                 "ds_read_b64_tr_b16 %6, %8 offset:96\n\tds_read_b64_tr_b16 %7, %8 offset:%12\n\t"
                 "s_waitcnt lgkmcnt(0)"
                 : "=&v"(a[0]), "=&v"(b[0]), "=&v"(a[1]), "=&v"(b[1]), "=&v"(a[2]), "=&v"(b[2]), "=&v"(a[3]), "=&v"(b[3])
                 : "v"(addr), "n"(16 * ROWB), "n"(16 * ROWB + 32), "n"(16 * ROWB + 64), "n"(16 * ROWB + 96) : "memory");
}
DI f32x4 mfma16(bf16x8 a, bf16x8 b, f32x4 c) { return __builtin_amdgcn_mfma_f32_16x16x32_bf16(a, b, c, 0, 0, 0); }
DI void unpack8(u32x4 v, float (&f)[8]) { f[0] = bflo(v.x); f[1] = bfhi(v.x); f[2] = bflo(v.y); f[3] = bfhi(v.y); f[4] = bflo(v.z); f[5] = bfhi(v.z); f[6] = bflo(v.w); f[7] = bfhi(v.w); }

namespace pg8 {
constexpr int BM = 256, BK = 64, HALF = 128, HTB = HALF * BK * 2, NXCD = 8, WGM = 8;
DI int lds_byte(int r, int c) { const int st = (r >> 4) * 2 + (c >> 5), rr = r & 15, cc = c & 31, ob = rr * 64 + cc * 2; return st * 1024 + (ob ^ (((ob >> 9) & 1) << 5)); }
DI void stage_rc(int b, int& R, int& C) { const int st = b / 1024, sb = b % 1024, swz = sb ^ (((sb >> 9) & 1) << 5); R = (st >> 1) * 16 + swz / 64; C = (st & 1) * 32 + (swz % 64) / 2; }
DI int perm32(int rho) { const int n = rho >> 4, i = rho & 15; return 8 * (i >> 2) + 4 * n + (i & 3); }
struct Unit { int pm, pn, kt0, ntu, split, half; };
struct Gemm { const bf16_t* A; const bf16_t* Bt; int M, N, K, lda; };
struct StaticOrder {
    int nM, nN, nwg, G, c, nt, sl;
    DI void init(int M, int N, int K, int G_, int c_, int sl_) { sl = sl_; nM = M / BM - (sl_ ? 1 : 0); nN = N / BM; nwg = nM * nN; G = G_; c = c_; nt = K / BK; }
    DI bool next(int i, Unit& u) const {
        const long L = (long)i * G + c;
        if (L >= nwg) { if (!sl) return false; const int idx = (int)(L - nwg), ns = nt / sl; if (idx >= nN * ns) return false;
            u.pm = nM; u.pn = idx % nN; u.kt0 = (idx / nN) * sl; u.ntu = sl; u.split = 1; u.half = 1; return true; }
        int wgid = (int)L; { const int q = nwg / NXCD, r = nwg % NXCD, xcd = wgid % NXCD, off = wgid / NXCD; wgid = (xcd < r ? xcd * (q + 1) : r * (q + 1) + (xcd - r) * q) + off; }
        const int nig = WGM * nN, gid = wgid / nig, fm = gid * WGM, gsz = (nM - fm) < WGM ? (nM - fm) : WGM;
        u.pm = fm + ((wgid % nig) % gsz); u.pn = (wgid % nig) / gsz; u.kt0 = 0; u.ntu = nt; u.split = 0; u.half = (u.pm == MP / BM) ? 1 : 0; return true;
    }
};
template <class Epi>
DI void gemm_phase(LAS unsigned char* lds, const Gemm g, const StaticOrder& S, const Epi& E) {
    const int tid = threadIdx.x, wid = __builtin_amdgcn_readfirstlane(tid >> 6), lane = tid & 63, wr = wid >> 2, wc = wid & 3, fr = lane & 15, fq = lane >> 4;
    const int K = g.K, lda = g.lda;
    unsigned voffA[2], voffB[2];
#pragma unroll
    for (int i = 0; i < 2; ++i) { int R, C; stage_rc(tid * 16 + i * 8192, R, C); const int Rb = Epi::PERM ? ((R & ~31) + perm32(R & 31)) : R;
        voffA[i] = (unsigned)(R * lda + C) * 2u; voffB[i] = (unsigned)(Rb * K + C) * 2u; }
    const size_t kstep = (size_t)(BK * 2);
    const size_t hstepA = (size_t)HALF * lda * 2, hstepB = (size_t)HALF * K * 2;
    const size_t tstepA = 2 * hstepA, tstepB = 2 * hstepB;
    const unsigned ldsw = (unsigned)wid * 1024u;
    const int aoff = lds_byte(wr * 64 + fr, fq * 8), boff = lds_byte(wc * 32 + fr, fq * 8);
#define PG8_SA(b, h) (((b) * 2 + (h)) * HTB)
#define PG8_SB(b, h) ((4 + (b) * 2 + (h)) * HTB)
#define PG8_STAGE(bufoff, gbase, voff) do { _Pragma("unroll") for (int _i = 0; _i < 2; ++_i) \
        __builtin_amdgcn_global_load_lds((const unsigned*)((const char*)(gbase) + (voff)[_i]), (LAS unsigned*)(lds + (bufoff) + ldsw + _i * 8192), 16, 0, 0); } while (0)
#define PG8_LDA(dst, b, h) do { _Pragma("unroll") for (int m = 0; m < 4; ++m) _Pragma("unroll") for (int k = 0; k < 2; ++k) dst[m][k] = *(const LAS bf16x8*)(lds + PG8_SA(b, h) + aoff + m * 2048 + k * 1024); } while (0)
#define PG8_LDB(dst, b, h) do { _Pragma("unroll") for (int n = 0; n < 2; ++n) _Pragma("unroll") for (int k = 0; k < 2; ++k) dst[n][k] = *(const LAS bf16x8*)(lds + PG8_SB(b, h) + boff + n * 2048 + k * 1024); } while (0)
#define PG8_MMA(ai, bj, At, Bt) do { __builtin_amdgcn_s_setprio(1); _Pragma("unroll") for (int m = 0; m < 4; ++m) _Pragma("unroll") for (int n = 0; n < 2; ++n) _Pragma("unroll") for (int k = 0; k < 2; ++k) \
        acc[ai][bj][m][n] = __builtin_amdgcn_mfma_f32_16x16x32_bf16(Bt[n][k], At[m][k], acc[ai][bj][m][n], 0, 0, 0); __builtin_amdgcn_s_setprio(0); } while (0)
#define PG8_WAIT_V(n) asm volatile("s_waitcnt vmcnt(" #n ")" ::: "memory")
#define PG8_WAIT_L(n) asm volatile("s_waitcnt lgkmcnt(" #n ")" ::: "memory")
#define PG8_BAR __builtin_amdgcn_s_barrier()
#define PG8_SCHED __builtin_amdgcn_sched_barrier(0)
    Unit cur, nxt; int ui = 0;
    if (!S.next(0, cur)) return;
    f32x4 acc[2][2][4][2];
#pragma unroll
    for (int a = 0; a < 2; ++a)
#pragma unroll
        for (int b = 0; b < 2; ++b)
#pragma unroll
            for (int m = 0; m < 4; ++m)
#pragma unroll
                for (int n = 0; n < 2; ++n) acc[a][b][m][n] = (f32x4){0.f, 0.f, 0.f, 0.f};
    bf16x8 At[4][2], B0[2][2], B1[2][2];
    const char* cA = (const char*)g.A + (size_t)cur.pm * tstepA + (size_t)cur.kt0 * kstep; const char* cB = (const char*)g.Bt + (size_t)cur.pn * tstepB + (size_t)cur.kt0 * kstep;
    PG8_STAGE(PG8_SB(0, 0), cB, voffB); PG8_STAGE(PG8_SA(0, 0), cA, voffA); PG8_STAGE(PG8_SB(0, 1), cB + hstepB, voffB); PG8_STAGE(PG8_SA(0, 1), cA + hstepA, voffA);
    if (wr == 1) PG8_BAR;
    PG8_WAIT_V(4); PG8_BAR;
    PG8_STAGE(PG8_SB(1, 0), cB + kstep, voffB); PG8_STAGE(PG8_SA(1, 0), cA + kstep, voffA); PG8_STAGE(PG8_SB(1, 1), cB + hstepB + kstep, voffB);
    PG8_WAIT_V(6); PG8_BAR;
    for (;;) {
        const bool has_next = S.next(ui + 1, nxt);
        const char* nA = has_next ? (const char*)g.A + (size_t)nxt.pm * tstepA + (size_t)nxt.kt0 * kstep : cA; const char* nB = has_next ? (const char*)g.Bt + (size_t)nxt.pn * tstepB + (size_t)nxt.kt0 * kstep : cB;
        const int nt = cur.ntu; const bool full = !cur.half;
        for (int t = 0; t < nt; t += 2) {
            const bool last = (t == nt - 2);
            const char* a1 = cA + (size_t)(t + 1) * kstep;
            const char* a2 = last ? nA : cA + (size_t)(t + 2) * kstep; const char* b2 = last ? nB : cB + (size_t)(t + 2) * kstep;
            const char* a3 = a2 + kstep; const char* b3 = b2 + kstep;
            PG8_LDB(B0, 0, 0); PG8_SCHED; PG8_LDA(At, 0, 0); PG8_STAGE(PG8_SA(1, 1), a1 + hstepA, voffA);
            PG8_WAIT_L(8); PG8_BAR; PG8_WAIT_L(0); PG8_MMA(0, 0, At, B0); PG8_BAR; PG8_SCHED;
            PG8_LDB(B1, 0, 1); PG8_STAGE(PG8_SB(0, 0), b2, voffB);
            PG8_BAR; PG8_WAIT_L(0); PG8_MMA(0, 1, At, B1); PG8_BAR;
            PG8_LDA(At, 0, 1); PG8_STAGE(PG8_SA(0, 0), a2, voffA);
            PG8_BAR; PG8_WAIT_L(0); if (full) PG8_MMA(1, 0, At, B0); PG8_BAR; PG8_SCHED;
            PG8_STAGE(PG8_SB(0, 1), b2 + hstepB, voffB);
            PG8_WAIT_V(6); PG8_BAR; if (full) PG8_MMA(1, 1, At, B1); PG8_BAR;
            PG8_LDB(B0, 1, 0); PG8_SCHED; PG8_LDA(At, 1, 0); PG8_STAGE(PG8_SA(0, 1), a2 + hstepA, voffA);
            PG8_WAIT_L(8); PG8_BAR; PG8_WAIT_L(0); PG8_MMA(0, 0, At, B0); PG8_BAR; PG8_SCHED;
            PG8_LDB(B1, 1, 1); PG8_STAGE(PG8_SB(1, 0), b3, voffB);
            PG8_BAR; PG8_WAIT_L(0); PG8_MMA(0, 1, At, B1); PG8_BAR;
            PG8_LDA(At, 1, 1); PG8_STAGE(PG8_SA(1, 0), a3, voffA);
            PG8_BAR; PG8_WAIT_L(0); if (full) PG8_MMA(1, 0, At, B0); PG8_BAR; PG8_SCHED;
            PG8_STAGE(PG8_SB(1, 1), b3 + hstepB, voffB);
            PG8_WAIT_V(6); PG8_BAR; if (full) PG8_MMA(1, 1, At, B1); PG8_BAR;
        }
        E(acc, cur, wr, wc, fr, fq);
        if (!has_next) break;
#pragma unroll
        for (int a = 0; a < 2; ++a)
#pragma unroll
            for (int b = 0; b < 2; ++b)
#pragma unroll
                for (int m = 0; m < 4; ++m)
#pragma unroll
                    for (int n = 0; n < 2; ++n) acc[a][b][m][n] = (f32x4){0.f, 0.f, 0.f, 0.f};
        cur = nxt; cA = nA; cB = nB; ++ui;
    }
    PG8_WAIT_V(0);
    if (wr == 0) PG8_BAR;
    PG8_BAR;
#undef PG8_SA
#undef PG8_SB
#undef PG8_STAGE
#undef PG8_LDA
#undef PG8_LDB
#undef PG8_MMA
#undef PG8_WAIT_V
#undef PG8_WAIT_L
#undef PG8_BAR
#undef PG8_SCHED
}
}
using pg8::Unit;

struct EpiSwiglu {
    static constexpr bool PERM = true; bf16_t* O;
    DI void operator()(const f32x4 (&acc)[2][2][4][2], const Unit& u, int wr, int wc, int fr, int fq) const {
        const int row0 = u.pm * 256 + wr * 64 + fr, col0 = u.pn * 128 + wc * 32 + 8 * fq;
#pragma unroll
        for (int ai = 0; ai < 2; ++ai) if (ai == 0 || !u.half)
#pragma unroll
            for (int m = 0; m < 4; ++m) { bf16_t* rowp = O + (size_t)(row0 + ai * 128 + m * 16) * FF + col0;
                const f32x4 g0 = acc[ai][0][m][0], g1 = acc[ai][0][m][1], u0 = acc[ai][1][m][0], u1 = acc[ai][1][m][1];
                u32x4 w; w.x = pk2(silu_f(g0[0]) * u0[0], silu_f(g0[1]) * u0[1]); w.y = pk2(silu_f(g0[2]) * u0[2], silu_f(g0[3]) * u0[3]);
                w.z = pk2(silu_f(g1[0]) * u1[0], silu_f(g1[1]) * u1[1]); w.w = pk2(silu_f(g1[2]) * u1[2], silu_f(g1[3]) * u1[3]);
                *(u32x4*)rowp = w; }
    }
};
struct EpiProj {
    static constexpr bool PERM = true; bf16_t* O; float* dtraw;
    DI void operator()(const f32x4 (&acc)[2][2][4][2], const Unit& u, int wr, int wc, int fr, int fq) const {
        const int row0 = u.pm * 256 + wr * 64 + fr, col0 = u.pn * 256 + wc * 32 + 8 * fq;
#pragma unroll
        for (int ai = 0; ai < 2; ++ai) if (ai == 0 || !u.half)
#pragma unroll
            for (int m = 0; m < 4; ++m) { const int row = row0 + ai * 128 + m * 16; bf16_t* rowp = O + (size_t)row * NINP + col0;
#pragma unroll
                for (int bj = 0; bj < 2; ++bj) { const f32x4 v0 = acc[ai][bj][m][0], v1 = acc[ai][bj][m][1];
                    u32x4 w; w.x = pk2(v0[0], v0[1]); w.y = pk2(v0[2], v0[3]); w.z = pk2(v1[0], v1[1]); w.w = pk2(v1[2], v1[3]);
                    *(u32x4*)(rowp + bj * 128) = w;
                    if (bj == 0 && u.pn == 34 && wc == 0 && fq < 3) { float* dp = dtraw + (size_t)row * 32 + 8 * fq; *(f32x4*)dp = v0; *(f32x4*)(dp + 4) = v1; } } }
    }
};
struct EpiF32 {
    static constexpr bool PERM = false; float* C;
    DI void operator()(const f32x4 (&acc)[2][2][4][2], const Unit& u, int wr, int wc, int fr, int fq) const {
        const int row0 = u.pm * 256 + wr * 64 + fr, col0 = u.pn * 256 + wc * 32 + 4 * fq;
        if (u.split) {
#pragma unroll
            for (int m = 0; m < 4; ++m) { float* rowp = C + (size_t)(row0 + m * 16) * D + col0;
#pragma unroll
                for (int bj = 0; bj < 2; ++bj)
#pragma unroll
                    for (int n = 0; n < 2; ++n)
#pragma unroll
                        for (int e = 0; e < 4; ++e) unsafeAtomicAdd(rowp + bj * 128 + n * 16 + e, acc[0][bj][m][n][e]); }
            return; }
#pragma unroll
        for (int ai = 0; ai < 2; ++ai) if (ai == 0 || !u.half)
#pragma unroll
            for (int m = 0; m < 4; ++m) { float* rowp = C + (size_t)(row0 + ai * 128 + m * 16) * D + col0;
#pragma unroll
                for (int bj = 0; bj < 2; ++bj)
#pragma unroll
                    for (int n = 0; n < 2; ++n) *(f32x4*)(rowp + bj * 128 + n * 16) = acc[ai][bj][m][n]; }
    }
};
template <int SECOND> struct EpiGate {
    static constexpr bool PERM = false; const bf16_t* proj; float* m1; bf16_t* merged;
    DI void operator()(const f32x4 (&acc)[2][2][4][2], const Unit& u, int wr, int wc, int fr, int fq) const {
        const int row0 = u.pm * 256 + wr * 64 + fr, col0 = u.pn * 256 + wc * 32 + 4 * fq;
#pragma unroll
        for (int ai = 0; ai < 2; ++ai) if (ai == 0 || !u.half)
#pragma unroll
            for (int m = 0; m < 4; ++m) { const size_t row = (size_t)(row0 + ai * 128 + m * 16);
#pragma unroll
                for (int bj = 0; bj < 2; ++bj)
#pragma unroll
                    for (int n = 0; n < 2; ++n) { const int c = col0 + bj * 128 + n * 16; const f32x4 a = acc[ai][bj][m][n];
                        const u32x2 gv = *(const u32x2*)(proj + row * NINP + OFF_GATE + SECOND * 1024 + c);
                        f32x4 r; r[0] = sigmoid_f(bflo(gv.x)) * a[0]; r[1] = sigmoid_f(bfhi(gv.x)) * a[1]; r[2] = sigmoid_f(bflo(gv.y)) * a[2]; r[3] = sigmoid_f(bfhi(gv.y)) * a[3];
                        if (SECOND == 0) *(f32x4*)(m1 + row * D + c) = r;
                        else { const f32x4 p = *(const f32x4*)(m1 + row * D + c); u32x2 o; o.x = pk2(p[0] + r[0], p[1] + r[1]); o.y = pk2(p[2] + r[2], p[3] + r[3]); *(u32x2*)(merged + row * D + c) = o; } } }
    }
};

#define XB_TMO      128
#define XB_XCNT(j)  (256  + 64 * (j))
#define XB_XSUB(j)  (1280 + 64 * (j))
#define XB_XGEN(j)  (2304 + 64 * (j))
#define XB_TOP      3328
#define XB_TOPGEN   3392
#define XCD_BAR_WORDS 3456
#define XB_SPIN_CAP (1u << 18)
DI unsigned xb_ld(unsigned* p)              { return __hip_atomic_load(p, __ATOMIC_RELAXED, __HIP_MEMORY_SCOPE_AGENT); }
DI unsigned xb_add(unsigned* p, unsigned v) { return __hip_atomic_fetch_add(p, v, __ATOMIC_RELAXED, __HIP_MEMORY_SCOPE_AGENT); }
DI unsigned xb_xcc_id() { return (unsigned)__builtin_amdgcn_s_getreg((3 << 11) | 20) & 0xFu; }
#define XB_SPIN(cond, bar) do { unsigned _sp = 0; while (cond) { __builtin_amdgcn_s_sleep(1); \
    if ((++_sp & 255u) == 0u) { if (xb_ld(&(bar)[XB_TMO])) break; if (_sp > XB_SPIN_CAP) { atomicAdd(&(bar)[XB_TMO], 1u); break; } } } } while (0)
struct XcdBarrier { unsigned* bar; unsigned x; volatile LAS unsigned* st; };
DI XcdBarrier xcd_barrier_post(unsigned* bar, volatile LAS unsigned* st) {
    XcdBarrier b; b.bar = bar; b.x = xb_xcc_id(); b.st = st;
    if (threadIdx.x == 0) (void)xb_add(&bar[XB_XCNT(b.x)], 1u);
    return b;
}
DI void xcd_barrier_complete(unsigned* bar, unsigned x, unsigned& nloc, unsigned& nx) {
    const unsigned G = gridDim.x * gridDim.y * gridDim.z;
    unsigned sum, cnt, mine, sp = 0u;
    for (;;) {
        sum = 0u; cnt = 0u; mine = 0u;
#pragma unroll
        for (unsigned j = 0; j < 16; ++j) { const unsigned c = xb_ld(&bar[XB_XCNT(j)]); sum += c; cnt += (c > 0u) ? 1u : 0u; mine = (j == x) ? c : mine; }
        if (sum == G) break;
        __builtin_amdgcn_s_sleep(1);
        if ((++sp & 255u) == 0u) { if (xb_ld(&bar[XB_TMO])) break; if (sp > XB_SPIN_CAP) { atomicAdd(&bar[XB_TMO], 1u); break; } }
    }
    nloc = mine > 0u ? mine : 1u; nx = cnt > 0u ? cnt : 1u;
}
DI void xcd_barrier(const XcdBarrier& b) {
    asm volatile("s_waitcnt vmcnt(0)" ::: "memory");
    __syncthreads();
    if (threadIdx.x == 0) {
        unsigned* bar = b.bar;
        __builtin_amdgcn_s_waitcnt(0);
        unsigned nloc = b.st[0], nx = b.st[1];
        if (nloc == 0u) { xcd_barrier_complete(bar, b.x, nloc, nx); b.st[0] = nloc; b.st[1] = nx; }
        const unsigned old = xb_add(&bar[XB_XSUB(b.x)], 1u);
        const unsigned gen = old / nloc;
        if (old + 1u == (gen + 1u) * nloc) {
            __builtin_amdgcn_fence(__ATOMIC_RELEASE, "agent");
            asm volatile("s_waitcnt vmcnt(0)" ::: "memory");
            const unsigned og = xb_add(&bar[XB_TOP], 1u);
            const unsigned tg = og / nx;
            if (og + 1u == (tg + 1u) * nx) xb_add(&bar[XB_TOPGEN], 1u);
            else XB_SPIN(xb_ld(&bar[XB_TOPGEN]) == tg, bar);
            __builtin_amdgcn_fence(__ATOMIC_ACQUIRE, "agent");
            xb_add(&bar[XB_XGEN(b.x)], 1u);
            asm volatile("s_waitcnt vmcnt(0)" ::: "memory");
        } else {
            XB_SPIN(xb_ld(&bar[XB_XGEN(b.x)]) == gen, bar);
            __builtin_amdgcn_fence(__ATOMIC_ACQUIRE, "agent");
            asm volatile("s_waitcnt vmcnt(0)" ::: "memory");
        }
    }
    __syncthreads();
}

struct Frame {
    float* out; unsigned char* ws; unsigned char* lds; int tid, lane, w, nblk, blk;
};
#define F_wgu1 ((bf16_t*)(F.ws + WS_WGU1))
#define F_wd1 ((bf16_t*)(F.ws + WS_WD1))
#define F_wgu2 ((bf16_t*)(F.ws + WS_WGU2))
#define F_wd2 ((bf16_t*)(F.ws + WS_WD2))
#define F_win ((bf16_t*)(F.ws + WS_WIN))
#define F_wa ((bf16_t*)(F.ws + WS_WA))
#define F_wb ((bf16_t*)(F.ws + WS_WB))
#define F_wo ((bf16_t*)(F.ws + WS_WO))
#define F_xn ((bf16_t*)(F.ws + WS_XN))
#define F_proj ((bf16_t*)(F.ws + WS_PROJ))
#define F_xbcc ((bf16_t*)(F.ws + WS_XBCC))
#define F_act ((bf16_t*)(F.ws + WS_ACT))
#define F_dtraw ((float*)(F.ws + WS_DTRAW))
#define F_newkv ((float*)(F.ws + WS_NEWKV))
#define F_cdec ((float*)(F.ws + WS_CDEC))
#define F_f ((float*)(F.ws + WS_F))
#define F_h (F.out)
#define F_sc ((unsigned char*)(F.out + O_KV2048S))
#define F_atto ((bf16_t*)(F_sc + SC_ATTO))
#define F_lse ((float*)(F_sc + SC_LSE))
#define F_states ((bf16_t*)(F_sc + SC_STATES))
#define F_m1 ((float*)(F_sc + SC_M1))

template <class Epi> DI void run_gemm(const Frame& F, const bf16_t* A, int lda, const bf16_t* Bt, int N, int K, const Epi& E, int split_sl = 0) {
    pg8::Gemm g; g.A = A; g.Bt = Bt; g.M = MT; g.N = N; g.K = K; g.lda = lda;
    pg8::StaticOrder S; S.init(MT, N, K, F.nblk, F.blk, split_sl);
    pg8::gemm_phase<Epi>((LAS unsigned char*)F.lds, g, S, E);
}

DI void zero_f_sample(const Frame& F) {
    f32x4* p = (f32x4*)(F_f + (size_t)MP * D);
    for (int i = F.blk * 512 + F.tid; i < 128 * 256; i += F.nblk * 512) p[i] = (f32x4){0.f, 0.f, 0.f, 0.f};
}
DI void transpose_item(const float* __restrict__ W, int K, int N, int NP, bf16_t* __restrict__ WT, float* scr, int item, int lane, int kind) {
    const int nblk = NP / 32, kb = item / nblk, nb = item % nblk, k0 = 64 * kb, n0 = 32 * nb;
    const int nn = n0 + (lane & 31);
    float tv[32];
#pragma unroll
    for (int i = 0; i < 32; ++i) { const int kk = 2 * i + (lane >> 5); tv[i] = nn < N ? W[(size_t)(k0 + kk) * N + nn] : 0.f; }
#pragma unroll
    for (int i = 0; i < 32; ++i) { const int kk = 2 * i + (lane >> 5); scr[kk * 33 + (lane & 31)] = tv[i]; }
    asm volatile("s_waitcnt lgkmcnt(0)" ::: "memory");
    const int c = lane & 7;
#pragma unroll
    for (int j = 0; j < 4; ++j) { const int n = (lane >> 3) + 8 * j; const float* s = scr + (8 * c) * 33 + n;
        u32x4 o; o.x = pk2(s[0 * 33], s[1 * 33]); o.y = pk2(s[2 * 33], s[3 * 33]); o.z = pk2(s[4 * 33], s[5 * 33]); o.w = pk2(s[6 * 33], s[7 * 33]);
        const int ng = n0 + n; const int row = kind == 0 ? ng : ((ng >> 7) * 256 + (ng & 127) + (kind == 2 ? 128 : 0));
        *(u32x4*)(WT + (size_t)row * K + k0 + 8 * c) = o; }
    asm volatile("s_waitcnt lgkmcnt(0)" ::: "memory");
}
DI void ld_row(const float* p, int lane, f32x4 (&v)[4]) { const f32x4* q = (const f32x4*)p + lane;
#pragma unroll
    for (int j = 0; j < 4; ++j) v[j] = q[64 * j]; }
DI float row_sumsq(const f32x4 (&v)[4]) { float s = 0.f;
#pragma unroll
    for (int j = 0; j < 4; ++j) s += (v[j][0] * v[j][0] + v[j][1] * v[j][1]) + (v[j][2] * v[j][2] + v[j][3] * v[j][3]);
    return wave_sum(s); }
DI void st_row_bf16(bf16_t* o, int lane, const f32x4 (&v)[4]) { u32x2* q = (u32x2*)o + lane;
#pragma unroll
    for (int j = 0; j < 4; ++j) { u32x2 t; t.x = pk2(v[j][0], v[j][1]); t.y = pk2(v[j][2], v[j][3]); q[64 * j] = t; } }
DI void st_row_f32(float* o, int lane, const f32x4 (&v)[4]) { f32x4* q = (f32x4*)o + lane;
#pragma unroll
    for (int j = 0; j < 4; ++j) q[64 * j] = v[j]; }

DI void phase_prep(const Params& P, const Frame& F) {
    float* scr = (float*)F.lds + F.w * (64 * 33 + 32);
    const int gw = F.blk * 8 + F.w, NGW = F.nblk * 8;
    constexpr int I_FU = 16 * 88, I_FD = 44 * 32, I_IN = 16 * (NINP / 32), I_A = 8 * 32, I_B = 24 * 32, I_O = 16 * 32;
    constexpr int NITEMS = 4 * I_FU + 2 * I_FD + I_IN + I_A + I_B + I_O;
    for (int it = gw; it < NITEMS; it += NGW) {
        int r = it;
        if (r < I_FU) { transpose_item(P.in[I_G1], 1024, FF, FF, F_wgu1, scr, r, F.lane, 1); continue; } r -= I_FU;
        if (r < I_FU) { transpose_item(P.in[I_U1], 1024, FF, FF, F_wgu1, scr, r, F.lane, 2); continue; } r -= I_FU;
        if (r < I_FU) { transpose_item(P.in[I_G2], 1024, FF, FF, F_wgu2, scr, r, F.lane, 1); continue; } r -= I_FU;
        if (r < I_FU) { transpose_item(P.in[I_U2], 1024, FF, FF, F_wgu2, scr, r, F.lane, 2); continue; } r -= I_FU;
        if (r < I_FD) { transpose_item(P.in[I_D1], FF, 1024, 1024, F_wd1, scr, r, F.lane, 0); continue; } r -= I_FD;
        if (r < I_FD) { transpose_item(P.in[I_D2], FF, 1024, 1024, F_wd2, scr, r, F.lane, 0); continue; } r -= I_FD;
        if (r < I_IN) { transpose_item(P.in[I_WIN], 1024, NIN, NINP, F_win, scr, r, F.lane, 0); continue; } r -= I_IN;
        if (r < I_A) { transpose_item(P.in[I_WA], 512, 1024, 1024, F_wa, scr, r, F.lane, 0); continue; } r -= I_A;
        if (r < I_B) { transpose_item(P.in[I_WB], 1536, 1024, 1024, F_wb, scr, r, F.lane, 0); continue; } r -= I_B;
        transpose_item(P.in[I_WO], 1024, 1024, 1024, F_wo, scr, r, F.lane, 0);
    }
    f32x4 g[4]; ld_row(P.in[I_GPRE1], F.lane, g);
    f32x4 v[4], vn[4];
    auto src_of = [&](int row) { return row < MP ? P.in[I_XP] + (size_t)row * D : P.in[I_XS] + (size_t)(row - MP) * D; };
    if (gw < MROWS) ld_row(src_of(gw), F.lane, v);
    for (int row = gw; row < MT; row += NGW) {
        const int nrow = row + NGW;
        if (nrow < MROWS) ld_row(src_of(nrow), F.lane, vn);
        if (row < MROWS) { const float rn = rsqrtf(row_sumsq(v) * (1.f / D) + EPS);
#pragma unroll
            for (int j = 0; j < 4; ++j) v[j] = v[j] * rn * g[j];
        } else {
#pragma unroll
            for (int j = 0; j < 4; ++j) v[j] = (f32x4){0.f, 0.f, 0.f, 0.f}; }
        st_row_bf16(F_xn + (size_t)row * D, F.lane, v);
#pragma unroll
        for (int j = 0; j < 4; ++j) v[j] = vn[j];
    }
}

template <int MODE> DI void phase_rows(const Params& P, const Frame& F) {
    const int gw = F.blk * 8 + F.w, NGW = F.nblk * 8;
    f32x4 gp[4], gn[4];
    ld_row(P.in[MODE == 0 ? I_GPOST1 : (MODE == 1 ? I_GPOSTM : I_GPOST2)], F.lane, gp);
    if (MODE < 2) ld_row(P.in[MODE == 0 ? I_GPREM : I_GPRE2], F.lane, gn);
    const float sc = MODE == 1 ? 1.f : 0.5f;
    f32x4 f[4], x[4], fn[4], xq[4];
    auto load_row = [&](int row, f32x4 (&ff)[4], f32x4 (&xx)[4]) {
        ld_row(F_f + (size_t)row * D, F.lane, ff);
        if (MODE == 0) ld_row(row < MP ? P.in[I_XP] + (size_t)row * D : P.in[I_XS] + (size_t)(row - MP) * D, F.lane, xx);
        else ld_row(F_h + (size_t)row * D, F.lane, xx); };
    if (gw < MROWS) load_row(gw, f, x);
    for (int row = gw; row < MROWS; row += NGW) {
        const int nrow = row + NGW;
        if (nrow < MROWS) load_row(nrow, fn, xq);
        const float rn = rsqrtf(row_sumsq(f) * (1.f / D) + EPS) * sc;
#pragma unroll
        for (int j = 0; j < 4; ++j) x[j] = x[j] + f[j] * rn * gp[j];
        st_row_f32(F_h + (size_t)row * D, F.lane, x);
        if (MODE < 2) {
            const float r2 = rsqrtf(row_sumsq(x) * (1.f / D) + EPS);
#pragma unroll
            for (int j = 0; j < 4; ++j) x[j] = x[j] * r2 * gn[j];
            st_row_bf16(F_xn + (size_t)row * D, F.lane, x);
        }
#pragma unroll
        for (int j = 0; j < 4; ++j) { f[j] = fn[j]; x[j] = xq[j]; }
    }
}

struct AttnRegs { u32x4 kv[4], vv[4]; bf16x8 qf[2]; };
DI void attn_decode(int unit, int& b, int& g, int& h, int& dil, int& r, int& n) {
    const int blk = unit & 63; h = (unit >> 6) & 7; const int bg = unit >> 9; g = bg % 3; b = bg / 3;
    dil = g == 0 ? 1 : (g == 1 ? 4 : 16); const int nb = 64 / dil; r = blk / nb; n = blk % nb;
}
DI void attn_fetch(const Frame& F, int unit, AttnRegs& R) {
    int b, g, h, dil, r, n; attn_decode(unit, b, g, h, dil, r, n);
    const bf16_t* proj = F_proj + (size_t)b * SEQ * NINP;
    const int qc = g * 1536 + h * 64, kc = qc + 512, vc = qc + 1024;
#pragma unroll
    for (int i = 0; i < 4; ++i) {
        const int idx = F.tid + 512 * i, key = idx >> 3, ch = idx & 7;
        const int ck = (n - 1) * 128 + key;
        R.kv[i] = (u32x4){0u, 0u, 0u, 0u}; R.vv[i] = (u32x4){0u, 0u, 0u, 0u};
        if (ck >= 0) { const bf16_t* rowp = proj + ((size_t)ck * dil + r) * NINP; R.kv[i] = *(const u32x4*)(rowp + kc + ch * 8); R.vv[i] = *(const u32x4*)(rowp + vc + ch * 8); }
    }
    const int qi = (F.tid >> 6) * 16 + (F.lane & 15), quad = F.lane >> 4;
    const size_t qtok = (size_t)(n * 128 + qi) * dil + r;
#pragma unroll
    for (int ks = 0; ks < 2; ++ks) R.qf[ks] = *(const bf16x8*)(proj + qtok * NINP + qc + ks * 32 + quad * 8);
}
DI void phase_attn(const Frame& F, int nrep) {
    const int tid = F.tid;
    bf16_t* Ks = (bf16_t*)F.lds;
    bf16_t* Vs = Ks + 256 * 72;
    const int total = 6144 * nrep;
    AttnRegs R;
    if (F.blk < total) attn_fetch(F, F.blk % 6144, R);
    for (int uu = F.blk; uu < total; uu += F.nblk) {
        const int unit = uu % 6144;
        int b, g, h, dil, r, n; attn_decode(unit, b, g, h, dil, r, n);
#pragma unroll
        for (int i = 0; i < 4; ++i) {
            const int idx = tid + 512 * i, key = idx >> 3, ch = idx & 7;
            *(u32x4*)(Ks + key * 72 + ch * 8) = R.kv[i];
            *(u32x4*)(Vs + key * 72 + ch * 8) = R.vv[i];
        }
        const bf16x8 qf0 = R.qf[0], qf1 = R.qf[1];
        lds_barrier();
        if (uu + F.nblk < total) attn_fetch(F, (uu + F.nblk) % 6144, R);
        const int w = tid >> 6, lane = F.lane, l15 = lane & 15, quad = lane >> 4;
        const int qi = w * 16 + l15;
        const size_t qtok = (size_t)(n * 128 + qi) * dil + r;
        const int kt0 = w & ~1;
        const unsigned vbase = (unsigned)(size_t)Vs + (unsigned)((quad * 4 + (l15 >> 2)) * 144 + (l15 & 3) * 8);
        f32x4 s[10];
#pragma unroll
        for (int t = 0; t < 10; ++t) { s[t] = (f32x4){0.f, 0.f, 0.f, 0.f};
            const bf16x8 kf0 = *(const bf16x8*)(Ks + ((kt0 + t) * 16 + l15) * 72 + quad * 8), kf1 = *(const bf16x8*)(Ks + ((kt0 + t) * 16 + l15) * 72 + 32 + quad * 8);
            s[t] = mfma16(kf0, qf0, s[t]); s[t] = mfma16(kf1, qf1, s[t]); }
        float m = -INFINITY;
#pragma unroll
        for (int t = 0; t < 10; ++t)
#pragma unroll
            for (int jj = 0; jj < 4; ++jj) { const int kj = (kt0 + t) * 16 + quad * 4 + jj; const bool valid = (kj >= qi) && (kj <= qi + 128) && (n > 0 || kj >= 128);
                const float v = valid ? s[t][jj] : -INFINITY; s[t][jj] = v; m = fmaxf(m, v); }
        m = fmaxf(m, __shfl_xor(m, 16)); m = fmaxf(m, __shfl_xor(m, 32));
        const float sc = 0.125f * 1.4426950408889634f;
        float den = 0.f;
#pragma unroll
        for (int t = 0; t < 10; ++t)
#pragma unroll
            for (int jj = 0; jj < 4; ++jj) { const float p = __builtin_amdgcn_exp2f((s[t][jj] - m) * sc); s[t][jj] = p; den += p; }
        den += __shfl_xor(den, 16); den += __shfl_xor(den, 32);
        f32x4 o[4];
#pragma unroll
        for (int et = 0; et < 4; ++et) o[et] = (f32x4){0.f, 0.f, 0.f, 0.f};
#pragma unroll
        for (int sg = 0; sg < 5; ++sg) {
            u32x4 pw; pw.x = pk2(s[2 * sg][0], s[2 * sg][1]); pw.y = pk2(s[2 * sg][2], s[2 * sg][3]); pw.z = pk2(s[2 * sg + 1][0], s[2 * sg + 1][1]); pw.w = pk2(s[2 * sg + 1][2], s[2 * sg + 1][3]);
            const bf16x8 pf = __builtin_bit_cast(bf16x8, pw);
            const int kb = (kt0 + 2 * sg) * 16;
            s16x4 lo[4], hi[4];
            tr8<144>(vbase + (unsigned)(kb * 144), lo, hi);
#pragma unroll
            for (int et = 0; et < 4; ++et) { const bf16x8 vf = __builtin_shufflevector(lo[et], hi[et], 0, 1, 2, 3, 4, 5, 6, 7); o[et] = mfma16(vf, pf, o[et]); }
        }
        const float inv = 1.f / den;
        const size_t grow = (size_t)b * SEQ + qtok;
        bf16_t* op = F_atto + grow * 1536 + g * 512 + h * 64 + quad * 4;
#pragma unroll
        for (int et = 0; et < 4; ++et) { u32x2 t; t.x = pk2(o[et][0] * inv, o[et][1] * inv); t.y = pk2(o[et][2] * inv, o[et][3] * inv); *(u32x2*)(op + et * 16) = t; }
        if (quad == 0) F_lse[grow * 24 + g * 8 + h] = m * 0.125f + __logf(den);
        lds_barrier();
    }
}

template <int NCOLS>
DI void conv_stage(const bf16_t* __restrict__ src, bool has_prev, const float* __restrict__ cw, const float* __restrict__ cb, bf16_t* dst, int ld, const float* dt_h, const float* cs_h, bf16_t* __restrict__ gdst, int tid) {
    constexpr int nch = NCOLS / 8, nseg = 512 / nch, rps = 128 / nseg;
    const int ch = tid % nch, seg = tid / nch, j0 = seg * rps;
    float wt[4][8], bias[8], xm[3][8];
#pragma unroll
    for (int t = 0; t < 4; ++t) { const f32x4 a = *(const f32x4*)(cw + t * 2560 + ch * 8), c = *(const f32x4*)(cw + t * 2560 + ch * 8 + 4);
        wt[t][0] = a[0]; wt[t][1] = a[1]; wt[t][2] = a[2]; wt[t][3] = a[3]; wt[t][4] = c[0]; wt[t][5] = c[1]; wt[t][6] = c[2]; wt[t][7] = c[3]; }
    { const f32x4 a = *(const f32x4*)(cb + ch * 8), c = *(const f32x4*)(cb + ch * 8 + 4);
        bias[0] = a[0]; bias[1] = a[1]; bias[2] = a[2]; bias[3] = a[3]; bias[4] = c[0]; bias[5] = c[1]; bias[6] = c[2]; bias[7] = c[3]; }
#pragma unroll
    for (int k = 0; k < 3; ++k) { const int j = j0 - 3 + k;
        if (j >= 0 || has_prev) { const u32x4 v = *(const u32x4*)(src + (ptrdiff_t)j * NINP + ch * 8); unpack8(v, xm[k]); }
        else {
#pragma unroll
            for (int e = 0; e < 8; ++e) xm[k][e] = 0.f; } }
    const float cl = dt_h ? cs_h[127] : 0.f;
#pragma unroll
    for (int r = 0; r < rps; ++r) { const int j = j0 + r; float x0[8], y[8];
        { const u32x4 v = *(const u32x4*)(src + (ptrdiff_t)j * NINP + ch * 8); unpack8(v, x0); }
#pragma unroll
        for (int e = 0; e < 8; ++e) { const float t = bias[e] + wt[0][e] * xm[0][e] + wt[1][e] * xm[1][e] + wt[2][e] * xm[2][e] + wt[3][e] * x0[e]; y[e] = silu_f(t); }
        { u32x4 o; o.x = pk2(y[0], y[1]); o.y = pk2(y[2], y[3]); o.z = pk2(y[4], y[5]); o.w = pk2(y[6], y[7]); *(u32x4*)(gdst + (size_t)j * 2560 + ch * 8) = o; }
        if (dst) { const float sc = dt_h ? dt_h[j] * __expf(cl - cs_h[j]) : 1.f;
#pragma unroll
            for (int e = 0; e < 8; ++e) dst[(ch * 8 + e) * ld + j] = f2bf(y[e] * sc); }
#pragma unroll
        for (int e = 0; e < 8; ++e) { xm[0][e] = xm[1][e]; xm[1][e] = xm[2][e]; xm[2][e] = x0[e]; }
    }
}
DI void dtcs_stage(const float* dtraw0, const float* dt_bias6, const float* a_log6, float* dt_s, float* cs_s, int w, int lane) {
    if (w < 6) { const float bias = dt_bias6[w], A = -__expf(a_log6[w]);
        const int j = 2 * lane; const float r0 = dtraw0[(size_t)j * 32 + w], r1 = dtraw0[(size_t)(j + 1) * 32 + w];
        const float d0 = softplus_f(r0 + bias), d1 = softplus_f(r1 + bias), a0 = d0 * A, a1 = d1 * A; float s = a0 + a1;
#pragma unroll
        for (int o = 1; o < 64; o <<= 1) { const float t = __shfl_up(s, o); if (lane >= o) s += t; }
        const float ex = s - (a0 + a1);
        dt_s[w * 128 + j] = d0; dt_s[w * 128 + j + 1] = d1; cs_s[w * 128 + j] = ex + a0; cs_s[w * 128 + j + 1] = ex + a0 + a1; }
}

DI void ssd1_unit(const Params& P, const Frame& F, int unit) {
    const int tid = F.tid, w = F.w, lane = F.lane, l15 = lane & 15, quad = lane >> 4;
    const int g = unit & 3, c = (unit >> 2) & 63, b = unit >> 8;
    const size_t tok0 = (size_t)b * SEQ + c * 128;
    bf16_t* BT = (bf16_t*)F.lds;
    bf16_t* xT = BT + 128 * 136;
    float* dt_s = (float*)(F.lds + 139264);
    float* cs_s = dt_s + 768;
    const bf16_t* src = F_proj + tok0 * NINP + OFF_XBC;
    bf16_t* gx = F_xbcc + tok0 * 2560;
    dtcs_stage(F_dtraw + tok0 * 32 + 6 * g, P.in[I_DTB] + 6 * g, P.in[I_ALOG] + 6 * g, dt_s, cs_s, w, lane);
    conv_stage<128>(src + 1536 + 128 * g, c > 0, P.in[I_CONVW] + 1536 + 128 * g, P.in[I_CONVB] + 1536 + 128 * g, BT, 136, nullptr, nullptr, gx + 1536 + 128 * g, tid);
    conv_stage<128>(src + 2048 + 128 * g, c > 0, P.in[I_CONVW] + 2048 + 128 * g, P.in[I_CONVB] + 2048 + 128 * g, nullptr, 136, nullptr, nullptr, gx + 2048 + 128 * g, tid);
    __syncthreads();
#pragma unroll 1
    for (int hh = 0; hh < 6; ++hh) { const int co = 384 * g + 64 * hh;
        conv_stage<64>(src + co, c > 0, P.in[I_CONVW] + co, P.in[I_CONVB] + co, xT + hh * 64 * 136, 136, dt_s + hh * 128, cs_s + hh * 128, gx + co, tid); }
    __syncthreads();
#pragma unroll 1
    for (int hh = 0; hh < 6; ++hh) {
        const int h = 6 * g + hh;
        f32x4 acc[4];
#pragma unroll
        for (int pt = 0; pt < 4; ++pt) acc[pt] = (f32x4){0.f, 0.f, 0.f, 0.f};
#pragma unroll
        for (int ks = 0; ks < 4; ++ks) { const bf16x8 xb = *(const bf16x8*)(BT + (w * 16 + l15) * 136 + ks * 32 + quad * 8);
#pragma unroll
            for (int pt = 0; pt < 4; ++pt) { const bf16x8 yb = *(const bf16x8*)(xT + (hh * 64 + pt * 16 + l15) * 136 + ks * 32 + quad * 8); acc[pt] = mfma16(xb, yb, acc[pt]); } }
        bf16_t* sp = F_states + ((size_t)(b * 64 + c) * 24 + h) * 8192 + w * 16 + quad * 4;
#pragma unroll
        for (int pt = 0; pt < 4; ++pt) { u32x2 t; t.x = pk2(acc[pt][0], acc[pt][1]); t.y = pk2(acc[pt][2], acc[pt][3]); *(u32x2*)(sp + (pt * 16 + l15) * 128) = t; }
        if (tid == 0) F_cdec[(b * 64 + c) * 24 + h] = __expf(cs_s[hh * 128 + 127]);
    }
    __syncthreads();
}

DI void phase_scan(const Frame& F) {
    const int total = 4 * 24 * 64 * 32, nthreads = F.nblk * 512;
    float* outp = F.out + O_SSMP;
    for (int it = F.blk * 512 + F.tid; it < total; it += nthreads) {
        const int n4 = it & 31, p = (it >> 5) & 63, h = (it >> 11) % 24, b = it / 49152;
        bf16_t* base = F_states + ((size_t)(b * 64) * 24 + h) * 8192 + p * 128 + n4 * 4;
        const float* dcp = F_cdec + (b * 64) * 24 + h;
        f32x4 run = (f32x4){0.f, 0.f, 0.f, 0.f};
        for (int c0 = 0; c0 < 64; c0 += 8) {
            u32x2 sv[8]; float dc[8];
#pragma unroll
            for (int k = 0; k < 8; ++k) { sv[k] = *(const u32x2*)(base + (size_t)(c0 + k) * 24 * 8192); dc[k] = dcp[(c0 + k) * 24]; }
#pragma unroll
            for (int k = 0; k < 8; ++k) { u32x2 pv; pv.x = pk2(run[0], run[1]); pv.y = pk2(run[2], run[3]); *(u32x2*)(base + (size_t)(c0 + k) * 24 * 8192) = pv;
                run[0] = run[0] * dc[k] + bflo(sv[k].x); run[1] = run[1] * dc[k] + bfhi(sv[k].x); run[2] = run[2] * dc[k] + bflo(sv[k].y); run[3] = run[3] * dc[k] + bfhi(sv[k].y); }
        }
        *(f32x4*)(outp + ((size_t)(b * 24 + h) * 64 + p) * 128 + n4 * 4) = run;
    }
}

DI void ssd3_unit(const Params& P, const Frame& F, int unit) {
    const int tid = F.tid, w = F.w, lane = F.lane, l15 = lane & 15, quad = lane >> 4;
    const int g = unit & 3, c = (unit >> 2) & 63, b = unit >> 8;
    const size_t tok0 = (size_t)b * SEQ + c * 128;
    bf16_t* Bs = (bf16_t*)F.lds;
    bf16_t* xs = Bs + 128 * 136;
    float* dt_s = (float*)(F.lds + 139264);
    float* cs_s = dt_s + 768;
    float* nw_s = cs_s + 768;
    const bf16_t* gx = F_xbcc + tok0 * 2560;
    dtcs_stage(F_dtraw + tok0 * 32 + 6 * g, P.in[I_DTB] + 6 * g, P.in[I_ALOG] + 6 * g, dt_s, cs_s, w, lane);
    if (tid < 96) *(f32x4*)(nw_s + tid * 4) = *(const f32x4*)(P.in[I_NORMW] + 384 * g + tid * 4);
#pragma unroll
    for (int k = 0; k < 4; ++k) { const int idx = tid + 512 * k, row = idx >> 4, ch = idx & 15;
        *(u32x4*)(Bs + row * 136 + ch * 8) = *(const u32x4*)(gx + (size_t)row * 2560 + 1536 + 128 * g + ch * 8); }
#pragma unroll 4
    for (int k = 0; k < 12; ++k) { const int idx = tid + 512 * k, row = idx / 48, ch = idx % 48;
        *(u32x4*)(xs + row * 400 + ch * 8) = *(const u32x4*)(gx + (size_t)row * 2560 + 384 * g + ch * 8); }
    const int i = w * 16 + l15;
    bf16x8 Cf[4];
#pragma unroll
    for (int ks = 0; ks < 4; ++ks) Cf[ks] = *(const bf16x8*)(gx + (size_t)i * 2560 + 2048 + 128 * g + ks * 32 + quad * 8);
    __syncthreads();
    f32x4 gt[8];
#pragma unroll
    for (int jt = 0; jt < 8; ++jt) { gt[jt] = (f32x4){0.f, 0.f, 0.f, 0.f};
        if (jt <= w) {
#pragma unroll
            for (int ks = 0; ks < 4; ++ks) { const bf16x8 xb = *(const bf16x8*)(Bs + (jt * 16 + l15) * 136 + ks * 32 + quad * 8); gt[jt] = mfma16(xb, Cf[ks], gt[jt]); } } }
    float ss = 0.f;
    const size_t orow = (tok0 + i) * NINP;
    const unsigned xbase = (unsigned)(size_t)xs + (unsigned)((quad * 4 + (l15 >> 2)) * 800 + (l15 & 3) * 8);
#pragma unroll 1
    for (int hh = 0; hh < 6; ++hh) {
        const int h = 6 * g + hh, h3 = hh;
        const float csi = cs_s[hh * 128 + i];
        u32x2 zv4[4];
#pragma unroll
        for (int pt = 0; pt < 4; ++pt) zv4[pt] = *(const u32x2*)(F_proj + orow + OFF_Z + 384 * g + hh * 64 + pt * 16 + quad * 4);
        f32x4 ya[4], off[4];
#pragma unroll
        for (int pt = 0; pt < 4; ++pt) { ya[pt] = (f32x4){0.f, 0.f, 0.f, 0.f}; off[pt] = (f32x4){0.f, 0.f, 0.f, 0.f}; }
#pragma unroll
        for (int sg = 0; sg < 4; ++sg) {
            if (2 * sg <= w) {
                float pv[8];
#pragma unroll
                for (int q = 0; q < 2; ++q) { const int jt = 2 * sg + q, jb = jt * 16 + quad * 4;
                    const f32x4 csj = *(const f32x4*)(cs_s + hh * 128 + jb), dtj = *(const f32x4*)(dt_s + hh * 128 + jb);
#pragma unroll
                    for (int jj = 0; jj < 4; ++jj) { const int j = jb + jj; const float e = __expf(fminf(csi - csj[jj], 0.f)) * dtj[jj]; pv[q * 4 + jj] = (j <= i) ? gt[jt][jj] * e : 0.f; } }
                u32x4 pw; pw.x = pk2(pv[0], pv[1]); pw.y = pk2(pv[2], pv[3]); pw.z = pk2(pv[4], pv[5]); pw.w = pk2(pv[6], pv[7]);
                const bf16x8 pf = __builtin_bit_cast(bf16x8, pw);
                s16x4 lo[4], hi[4];
                tr8<800>(xbase + (unsigned)(sg * 32 * 800 + h3 * 128), lo, hi);
#pragma unroll
                for (int pt = 0; pt < 4; ++pt) { const bf16x8 xf = __builtin_shufflevector(lo[pt], hi[pt], 0, 1, 2, 3, 4, 5, 6, 7); ya[pt] = mfma16(xf, pf, ya[pt]); }
            }
        }
        const bf16_t* pr = F_states + ((size_t)(b * 64 + c) * 24 + h) * 8192;
#pragma unroll
        for (int pt = 0; pt < 4; ++pt)
#pragma unroll
            for (int ks = 0; ks < 4; ++ks) { const bf16x8 xb = *(const bf16x8*)(pr + (pt * 16 + l15) * 128 + ks * 32 + quad * 8); off[pt] = mfma16(xb, Cf[ks], off[pt]); }
        const float ecs = __expf(csi), Dh = P.in[I_DSKIP][h];
#pragma unroll
        for (int pt = 0; pt < 4; ++pt) { const int p0 = pt * 16 + quad * 4;
            const u32x2 zv = zv4[pt];
            const float z[4] = {bflo(zv.x), bfhi(zv.x), bflo(zv.y), bfhi(zv.y)};
            float yv[4]; const u32x2 xr2 = *(const u32x2*)(xs + i * 400 + h3 * 64 + p0); const float xv4[4] = {bflo(xr2.x), bfhi(xr2.x), bflo(xr2.y), bfhi(xr2.y)};
#pragma unroll
            for (int jj = 0; jj < 4; ++jj) { yv[jj] = (ya[pt][jj] + off[pt][jj] * ecs + Dh * xv4[jj]) * silu_f(z[jj]); ss += yv[jj] * yv[jj]; }
            u32x2 t; t.x = pk2(yv[0], yv[1]); t.y = pk2(yv[2], yv[3]);
            *(u32x2*)(F_proj + orow + 512 + 384 * g + hh * 64 + p0) = t; }
    }
    ss += __shfl_xor(ss, 16); ss += __shfl_xor(ss, 32);
    const float rn = rsqrtf(ss * (1.f / 384.f) + EPS);
    u32x2 yb[6][4];
#pragma unroll
    for (int hh = 0; hh < 6; ++hh)
#pragma unroll
        for (int pt = 0; pt < 4; ++pt) yb[hh][pt] = *(const u32x2*)(F_proj + orow + 512 + 384 * g + hh * 64 + pt * 16 + quad * 4);
#pragma unroll
    for (int hh = 0; hh < 6; ++hh)
#pragma unroll
        for (int pt = 0; pt < 4; ++pt) { const int cc = hh * 64 + pt * 16 + quad * 4; const f32x4 wv = *(const f32x4*)(nw_s + cc); const u32x2 yv = yb[hh][pt];
            u32x2 t; t.x = pk2(bflo(yv.x) * rn * wv[0], bfhi(yv.x) * rn * wv[1]); t.y = pk2(bflo(yv.y) * rn * wv[2], bfhi(yv.y) * rn * wv[3]);
            *(u32x2*)(F_proj + orow + 512 + 384 * g + cc) = t; }
    __syncthreads();
}

DI void sample_ssd_item(const Params& P, const Frame& F, int item) {
    const int tid = F.tid, w = F.w, lane = F.lane;
    const int b = item >> 2, g = item & 3;
    float* xs = (float*)F.lds;
    float* Bs = xs + 1536;
    float* Cs = Bs + 512;
    float* dts = Cs + 512;
    float* yg = dts + 32;
    const size_t row0 = (size_t)MP + 4 * b;
    for (int idx = tid; idx < 640; idx += 512) {
        const int col = idx < 384 ? 384 * g + idx : (idx < 512 ? 1536 + 128 * g + (idx - 384) : 2048 + 128 * g + (idx - 512));
        float xp[7];
#pragma unroll
        for (int k = 0; k < 3; ++k) xp[k] = P.in[I_SCONV][((size_t)b * 3 + k) * 2560 + col];
#pragma unroll
        for (int l = 0; l < 4; ++l) xp[3 + l] = bf2f(F_proj[(row0 + l) * NINP + OFF_XBC + col]);
        const float w0 = P.in[I_CONVW][col], w1 = P.in[I_CONVW][2560 + col], w2 = P.in[I_CONVW][5120 + col], w3 = P.in[I_CONVW][7680 + col], bs = P.in[I_CONVB][col];
#pragma unroll
        for (int l = 0; l < 4; ++l) { const float y = silu_f(bs + w0 * xp[l] + w1 * xp[l + 1] + w2 * xp[l + 2] + w3 * xp[l + 3]);
            if (idx < 384) xs[l * 384 + idx] = y; else if (idx < 512) Bs[l * 128 + idx - 384] = y; else Cs[l * 128 + idx - 512] = y; }
    }
    if (tid < 24) { const int l = tid / 6, hh = tid % 6; dts[l * 8 + hh] = softplus_f(F_dtraw[(row0 + l) * 32 + 6 * g + hh] + P.in[I_DTB][6 * g + hh]); }
    __syncthreads();
    const int p = tid >> 3, nq = tid & 7;
#pragma unroll 1
    for (int hh = 0; hh < 6; ++hh) {
        const int h = 6 * g + hh; const float A = -__expf(P.in[I_ALOG][h]), Dh = P.in[I_DSKIP][h];
        const size_t so = ((size_t)(b * 24 + h) * 64 + p) * 128 + nq * 16;
        f32x4 s[4];
#pragma unroll
        for (int q = 0; q < 4; ++q) s[q] = *(const f32x4*)(P.in[I_SSSM] + so + 4 * q);
#pragma unroll
        for (int l = 0; l < 4; ++l) { const float dt = dts[l * 8 + hh], dA = __expf(dt * A), xv = xs[l * 384 + hh * 64 + p], dx = dt * xv; float yp = 0.f;
#pragma unroll
            for (int q = 0; q < 4; ++q) { const f32x4 Bv = *(const f32x4*)(Bs + l * 128 + nq * 16 + 4 * q), Cv = *(const f32x4*)(Cs + l * 128 + nq * 16 + 4 * q);
                s[q] = s[q] * dA + Bv * dx; yp += (Cv[0] * s[q][0] + Cv[1] * s[q][1]) + (Cv[2] * s[q][2] + Cv[3] * s[q][3]); }
            yp += __shfl_xor(yp, 1); yp += __shfl_xor(yp, 2); yp += __shfl_xor(yp, 4);
            if (nq == 0) { const float z = bf2f(F_proj[(row0 + l) * NINP + OFF_Z + 384 * g + hh * 64 + p]); yg[l * 384 + hh * 64 + p] = (yp + Dh * xv) * silu_f(z); } }
#pragma unroll
        for (int q = 0; q < 4; ++q) *(f32x4*)(F.out + O_SSMS + so + 4 * q) = s[q];
    }
    __syncthreads();
    if (w < 4) { const int l = w; float v[6]; float ss = 0.f;
#pragma unroll
        for (int k = 0; k < 6; ++k) { v[k] = yg[l * 384 + lane + 64 * k]; ss += v[k] * v[k]; }
        ss = wave_sum(ss); const float rn = rsqrtf(ss * (1.f / 384.f) + EPS);
#pragma unroll
        for (int k = 0; k < 6; ++k) { const int col = lane + 64 * k; F_proj[(row0 + l) * NINP + 512 + 384 * g + col] = f2bf(v[k] * rn * P.in[I_NORMW][384 * g + col]); } }
    __syncthreads();
}

DI void sample_attn_item(const Params& P, const Frame& F, int item) {
    const int tid = F.tid, w = F.w, lane = F.lane;
    const int b = item >> 3, h = item & 7;
    float* qs = (float*)F.lds + w * 256;
    float* ps = qs + 64;
    float* ores = (float*)F.lds + 8 * 256;
    float* lres = ores + 12 * 64;
    const size_t row0 = (size_t)MP + 4 * b;
#pragma unroll 1
    for (int rnd = 0; rnd < 2; ++rnd) {
        const int task = w + 8 * rnd;
        if (task < 12) {
            const int g = task >> 2, l = task & 3;
            const int W = g == 0 ? 128 : (g == 1 ? 512 : 2048), d = g == 0 ? 1 : (g == 1 ? 4 : 16);
            const float* cache = (g == 0 ? P.in[I_C128] : (g == 1 ? P.in[I_C512] : P.in[I_C2048]));
            const int qc = g * 1536 + h * 64;
            qs[lane] = bf2f(F_proj[(row0 + l) * NINP + qc + lane]) * 0.125f;
            asm volatile("s_waitcnt lgkmcnt(0)" ::: "memory");
            float sc[3];
#pragma unroll
            for (int r3 = 0; r3 < 3; ++r3) { const int j = lane + 64 * r3; float dot = -INFINITY;
                if (j <= 128) { const int idx = W + l - d * j; dot = 0.f;
                    if (idx >= W) { const bf16_t* kp = F_proj + (row0 + (idx - W)) * NINP + qc + 512;
#pragma unroll
                        for (int e8 = 0; e8 < 8; ++e8) { float kf[8]; unpack8(*(const u32x4*)(kp + e8 * 8), kf);
#pragma unroll
                            for (int e = 0; e < 8; ++e) dot += kf[e] * qs[e8 * 8 + e]; }
                    } else { const float* kp = cache + (((size_t)b * W + idx) * 2 * 8 + h) * 64;
#pragma unroll
                        for (int e4 = 0; e4 < 16; ++e4) { const f32x4 kk = *(const f32x4*)(kp + e4 * 4); const f32x4 qq = *(const f32x4*)(qs + e4 * 4);
                            dot += (kk[0] * qq[0] + kk[1] * qq[1]) + (kk[2] * qq[2] + kk[3] * qq[3]); } } }
                sc[r3] = dot; }
            const float m = wave_max(fmaxf(fmaxf(sc[0], sc[1]), sc[2]));
            float dsum = 0.f;
#pragma unroll
            for (int r3 = 0; r3 < 3; ++r3) { const float p = __expf(sc[r3] - m); dsum += p; ps[lane + 64 * r3] = p; }
            const float den = wave_sum(dsum);
            asm volatile("s_waitcnt lgkmcnt(0)" ::: "memory");
            const int e4 = lane & 15, sub = lane >> 4;
            f32x4 acc = (f32x4){0.f, 0.f, 0.f, 0.f};
#pragma unroll 11
            for (int j = sub; j <= 128; j += 4) { const int idx = W + l - d * j; const float p = ps[j]; f32x4 vv;
                if (idx >= W) { const u32x2 t = *(const u32x2*)(F_proj + (row0 + (idx - W)) * NINP + qc + 1024 + e4 * 4); vv[0] = bflo(t.x); vv[1] = bfhi(t.x); vv[2] = bflo(t.y); vv[3] = bfhi(t.y); }
                else vv = *(const f32x4*)(cache + ((((size_t)b * W + idx) * 2 + 1) * 8 + h) * 64 + e4 * 4);
                acc += vv * p; }
#pragma unroll
            for (int q = 0; q < 4; ++q) { acc[q] += __shfl_xor(acc[q], 16); acc[q] += __shfl_xor(acc[q], 32); }
            if (sub == 0) *(f32x4*)(ores + task * 64 + e4 * 4) = acc * (1.f / den);
            if (lane == 0) lres[task] = m + __logf(den);
            { const int kv = lane >> 5, e2 = (lane & 31) * 2; const unsigned t = *(const unsigned*)(F_proj + (row0 + l) * NINP + qc + 512 + kv * 512 + e2);
              float* dp = F_newkv + ((((size_t)(4 * b + l) * 3 + g) * 2 + kv) * 8 + h) * 64 + e2; dp[0] = bflo(t); dp[1] = bfhi(t); }
        }
    }
    __syncthreads();
    if (tid < 256) { const int l = tid >> 6, e = tid & 63;
        const float l0 = lres[l], l1 = lres[4 + l], l2 = lres[8 + l], mm = fmaxf(fmaxf(l0, l1), l2);
        const float a0 = __expf(l0 - mm), a1 = __expf(l1 - mm), a2 = __expf(l2 - mm), inv = 1.f / (a0 + a1 + a2);
        const float o = (a0 * ores[l * 64 + e] + a1 * ores[(4 + l) * 64 + e] + a2 * ores[(8 + l) * 64 + e]) * inv;
        F_proj[(row0 + l) * NINP + h * 64 + e] = f2bf(o); }
    __syncthreads();
}

DI void copy_row_bf16_f32(const bf16_t* src, float* dst, int n512, int lane) {
    for (int jj = 0; jj < n512; ++jj) { const int e0 = lane * 8 + 512 * jj; float f[8]; unpack8(*(const u32x4*)(src + e0), f);
        *(f32x4*)(dst + e0) = (f32x4){f[0], f[1], f[2], f[3]}; *(f32x4*)(dst + e0 + 4) = (f32x4){f[4], f[5], f[6], f[7]}; }
}
DI void phase5_copies(const Frame& F) {
    const int gw = F.blk * 8 + F.w, NGW = F.nblk * 8;
    for (int rr = gw; rr < 10752 + 12 + 96; rr += NGW) {
        if (rr < 10752) { int q = rr, g, W; size_t ob;
            if (q < 512) { g = 0; W = 128; ob = O_KV128P; } else if (q < 2560) { q -= 512; g = 1; W = 512; ob = O_KV512P; } else { q -= 2560; g = 2; W = 2048; ob = O_KV2048P; }
            const int b = q / W, i = q % W;
            copy_row_bf16_f32(F_proj + ((size_t)b * SEQ + SEQ - W + i) * NINP + g * 1536 + 512, F.out + ob + ((size_t)b * W + i) * 1024, 2, F.lane);
        } else if (rr < 10764) { const int q = rr - 10752, b = q / 3, i = q % 3;
            copy_row_bf16_f32(F_proj + ((size_t)b * SEQ + SEQ - 3 + i) * NINP + OFF_XBC, F.out + O_CONVP + (size_t)q * 2560, 5, F.lane);
        } else { const int q = rr - 10764, b = q / 3, i = q % 3;
            copy_row_bf16_f32(F_proj + ((size_t)MP + 4 * b + 1 + i) * NINP + OFF_XBC, F.out + O_CONVS + (size_t)q * 2560, 5, F.lane); }
    }
}
DI void phase7_combine(const Frame& F) {
    const int gw = F.blk * 8 + F.w, NGW = F.nblk * 8, lane = F.lane, h = lane >> 3;
    for (int row0 = gw; row0 < MP; row0 += 4 * NGW) {
        float l[4][3]; u32x4 v[4][3];
#pragma unroll
        for (int r = 0; r < 4; ++r) { const int row = row0 + r * NGW; if (row < MP) {
            const float* lp = F_lse + (size_t)row * 24 + h; l[r][0] = lp[0]; l[r][1] = lp[8]; l[r][2] = lp[16];
            const bf16_t* op = F_atto + (size_t)row * 1536 + lane * 8; v[r][0] = *(const u32x4*)op; v[r][1] = *(const u32x4*)(op + 512); v[r][2] = *(const u32x4*)(op + 1024); } }
#pragma unroll
        for (int r = 0; r < 4; ++r) { const int row = row0 + r * NGW; if (row < MP) {
            const float mm = fmaxf(fmaxf(l[r][0], l[r][1]), l[r][2]);
            const float a0 = __expf(l[r][0] - mm), a1 = __expf(l[r][1] - mm), a2 = __expf(l[r][2] - mm), inv = 1.f / (a0 + a1 + a2);
            float f0[8], f1[8], f2[8], o[8]; unpack8(v[r][0], f0); unpack8(v[r][1], f1); unpack8(v[r][2], f2);
#pragma unroll
            for (int e = 0; e < 8; ++e) o[e] = (a0 * f0[e] + a1 * f1[e] + a2 * f2[e]) * inv;
            u32x4 t; t.x = pk2(o[0], o[1]); t.y = pk2(o[2], o[3]); t.z = pk2(o[4], o[5]); t.w = pk2(o[6], o[7]);
            *(u32x4*)(F_proj + (size_t)row * NINP + lane * 8) = t; } }
    }
}
template <int G> DI void kvcopy_range(const float* __restrict__ cache, float* __restrict__ outp, size_t q_lo, size_t q_hi, int rank, int nranks, int tid) {
    constexpr int W = G == 0 ? 128 : (G == 1 ? 512 : 2048);
    const size_t nthreads = (size_t)nranks * 512;
    for (size_t q0 = q_lo + (size_t)rank * 512 + tid; q0 < q_hi; q0 += 4 * nthreads) {
        f32x4 v[4];
#pragma unroll
        for (int k = 0; k < 4; ++k) { const size_t q = q0 + k * nthreads; if (q < q_hi) {
            const int row = (int)(q >> 8), c4 = (int)(q & 255), b = row / W, i = row % W;
            if (i + 4 < W) v[k] = *(const f32x4*)(cache + ((size_t)b * W + i + 4) * 1024 + c4 * 4); } }
#pragma unroll
        for (int k = 0; k < 4; ++k) { const size_t q = q0 + k * nthreads; if (q < q_hi) { const int i = (int)(q >> 8) % W; if (i + 4 < W) *(f32x4*)(outp + q * 4) = v[k]; } }
    }
}
template <int G> DI void kvcopy_new(const float* __restrict__ newkv, float* __restrict__ outp, int blk, int nblk, int tid) {
    constexpr int W = G == 0 ? 128 : (G == 1 ? 512 : 2048);
    for (int q = blk * 512 + tid; q < 32 * 4 * 256; q += nblk * 512) { const int c4 = q & 255, l = (q >> 8) & 3, b = q >> 10;
        *(f32x4*)(outp + ((size_t)b * W + W - 4 + l) * 1024 + c4 * 4) = *(const f32x4*)(newkv + ((size_t)(4 * b + l) * 3 + G) * 1024 + c4 * 4); }
}
constexpr size_t KV2_TOTAL = (size_t)32 * 2048 * 256, KV2_A = (KV2_TOTAL * 27 / 100) & ~(size_t)255, KV2_B = (KV2_TOTAL * 54 / 100) & ~(size_t)255, KV2_C = (KV2_TOTAL * 84 / 100) & ~(size_t)255, KV2_D = (KV2_TOTAL * 91 / 100) & ~(size_t)255;
static_assert(KV2_B * 16 >= (size_t)MT * 1024 * 4, "the part copied while m1 is live must lie behind it");
template <int WHICH> DI void kv_filler(const Params& P, const Frame& F, int ntail) {
    if (F.blk < ntail || F.nblk <= ntail) return;
    const int rank = F.blk - ntail, nranks = F.nblk - ntail;
    if (WHICH == 0) kvcopy_range<1>(P.in[I_C512], F.out + O_KV512S, 0, (size_t)32 * 512 * 256, rank, nranks, F.tid);
    if (WHICH == 1) kvcopy_range<0>(P.in[I_C128], F.out + O_KV128S, 0, (size_t)32 * 128 * 256, rank, nranks, F.tid);
    if (WHICH == 2) kvcopy_range<2>(P.in[I_C2048], F.out + O_KV2048S, 0, KV2_A, rank, nranks, F.tid);
    if (WHICH == 3) kvcopy_range<2>(P.in[I_C2048], F.out + O_KV2048S, KV2_A, KV2_B, rank, nranks, F.tid);
    if (WHICH == 5) kvcopy_range<2>(P.in[I_C2048], F.out + O_KV2048S, KV2_C, KV2_D, rank, nranks, F.tid);
    if (WHICH == 4) kvcopy_range<2>(P.in[I_C2048], F.out + O_KV2048S, KV2_B, KV2_C, rank, nranks, F.tid);
}
DI void phase_kvcopy(const Params& P, const Frame& F) {
    if (F.nblk <= 22) {
        kvcopy_range<1>(P.in[I_C512], F.out + O_KV512S, 0, (size_t)32 * 512 * 256, F.blk, F.nblk, F.tid);
        kvcopy_range<0>(P.in[I_C128], F.out + O_KV128S, 0, (size_t)32 * 128 * 256, F.blk, F.nblk, F.tid);
        kvcopy_range<2>(P.in[I_C2048], F.out + O_KV2048S, 0, KV2_C, F.blk, F.nblk, F.tid); }
    if (F.nblk <= 44) kvcopy_range<2>(P.in[I_C2048], F.out + O_KV2048S, KV2_C, KV2_D, F.blk, F.nblk, F.tid);
    kvcopy_range<2>(P.in[I_C2048], F.out + O_KV2048S, KV2_D, KV2_TOTAL, F.blk, F.nblk, F.tid);
    kvcopy_new<0>(F_newkv, F.out + O_KV128S, F.blk, F.nblk, F.tid);
    kvcopy_new<1>(F_newkv, F.out + O_KV512S, F.blk, F.nblk, F.tid);
    kvcopy_new<2>(F_newkv, F.out + O_KV2048S, F.blk, F.nblk, F.tid);
}

__global__ void __launch_bounds__(512, 2) fwd_megakernel(Params P) {
    extern __shared__ __attribute__((aligned(16))) unsigned char shm[];
    cg::grid_group grid = cg::this_grid();
    Frame F; F.out = P.out; F.ws = P.ws; F.lds = shm; F.tid = threadIdx.x; F.lane = threadIdx.x & 63; F.w = __builtin_amdgcn_readfirstlane(threadIdx.x >> 6); F.nblk = gridDim.x; F.blk = blockIdx.x;

    volatile LAS unsigned* bst = (volatile LAS unsigned*)(LAS unsigned char*)(shm + LDS_BAR_OFF);
    if (threadIdx.x < 2) bst[threadIdx.x] = 0u;
    __syncthreads();
    const XcdBarrier XB = xcd_barrier_post((unsigned*)(P.ws + WS_BAR), bst);
#define GSYNC(k) do { if ((k) == 0) { asm volatile("s_waitcnt vmcnt(0)" ::: "memory"); grid.sync(); } else xcd_barrier(XB); } while (0)
#define PHASE(k, body) do { if ((PHASE_MASK & (1 << (k))) && P.ph_lo <= (k) && (k) < P.ph_hi) { body if (DOUBLE_MASK & (1 << (k))) { GSYNC(1); body } } if (P.ph_lo <= (k) && (k) + 1 < P.ph_hi) GSYNC(k); } while (0)
    PHASE(0, phase_prep(P, F););
    PHASE(1, { zero_f_sample(F); EpiSwiglu E; E.O = F_act; run_gemm(F, F_xn, 1024, F_wgu1, 5632, 1024, E); kv_filler<0>(P, F, 22); });
    PHASE(2, { EpiF32 E; E.C = F_f; run_gemm(F, F_act, FF, F_wd1, 1024, FF, E, 4); });
    PHASE(3, phase_rows<0>(P, F););
    PHASE(4, { EpiProj E; E.O = F_proj; E.dtraw = F_dtraw; run_gemm(F, F_xn, 1024, F_win, NINP, 1024, E); });
    PHASE(5, {
        if (SUB_MASK & 1) phase_attn(F, (DOUBLE_SUB & 1) ? 2 : 1);
        if (SUB_MASK & 2) for (int rep = 0; rep < ((DOUBLE_SUB & 2) ? 2 : 1); ++rep) for (int u = F.blk; u < 1024; u += F.nblk) ssd1_unit(P, F, u);
        if (SUB_MASK & 4) for (int u = F.blk; u < 256; u += F.nblk) sample_attn_item(P, F, u);
        if (SUB_MASK & 8) phase5_copies(F); });
    PHASE(6, { phase_scan(F); if (SUB_MASK & 32) for (int u = (F.blk + F.nblk / 2) % F.nblk; u < 128; u += F.nblk) sample_ssd_item(P, F, u); });
    PHASE(7, {
        if (SUB_MASK & 16) for (int rep = 0; rep < ((DOUBLE_SUB & 16) ? 2 : 1); ++rep) for (int u = F.blk; u < 1024; u += F.nblk) ssd3_unit(P, F, u);
        if (SUB_MASK & 64) for (int rep = 0; rep < ((DOUBLE_SUB & 64) ? 2 : 1); ++rep) phase7_combine(F); });
    PHASE(8, { EpiGate<0> E; E.proj = F_proj; E.m1 = F_m1; E.merged = F_xn; run_gemm(F, F_proj, NINP, F_wa, 1024, 512, E); kv_filler<1>(P, F, 4); });
    PHASE(9, { EpiGate<1> E; E.proj = F_proj; E.m1 = F_m1; E.merged = F_xn; run_gemm(F, F_proj + 512, NINP, F_wb, 1024, 1536, E); kv_filler<4>(P, F, 4); });
    PHASE(10, { EpiF32 E; E.C = F_f; run_gemm(F, F_xn, 1024, F_wo, 1024, 1024, E); kv_filler<2>(P, F, 4); });
    PHASE(11, phase_rows<1>(P, F););
    PHASE(12, { zero_f_sample(F); EpiSwiglu E; E.O = F_act; run_gemm(F, F_xn, 1024, F_wgu2, 5632, 1024, E); kv_filler<3>(P, F, 22); });
    PHASE(13, { EpiF32 E; E.C = F_f; run_gemm(F, F_act, FF, F_wd2, 1024, FF, E, 4); kv_filler<5>(P, F, 44); });
    PHASE(14, { phase_rows<2>(P, F); phase_kvcopy(P, F); });
}

extern "C" void kernel_launch(void* const* d_in, const int* in_sizes, int n_in, void* d_out, int out_size, void* d_ws, size_t ws_size, hipStream_t stream) {
    static int grid_blocks = 0;
    if (grid_blocks == 0) {
        if (n_in != 29 || (size_t)out_size != O_TOTAL || ws_size < WS_END) { fprintf(stderr, "kernel_launch: unexpected shapes: n_in %d out %d ws %zu (need %zu)\n", n_in, out_size, ws_size, (size_t)WS_END); grid_blocks = -1; return; }
        int dev = 0, cus = 0, per_cu = 0;
        hipGetDevice(&dev); hipDeviceGetAttribute(&cus, hipDeviceAttributeMultiprocessorCount, dev);
        if (hipFuncSetAttribute((const void*)fwd_megakernel, hipFuncAttributeMaxDynamicSharedMemorySize, LDS_BYTES) != hipSuccess) { fprintf(stderr, "kernel_launch: hipFuncSetAttribute failed\n"); grid_blocks = -1; return; }
        hipOccupancyMaxActiveBlocksPerMultiprocessor(&per_cu, (const void*)fwd_megakernel, 512, LDS_BYTES);
        if (per_cu < 1) { fprintf(stderr, "kernel_launch: occupancy query says %d blocks per CU\n", per_cu); grid_blocks = -1; return; }
        grid_blocks = cus;
    }
    if (grid_blocks < 0) return;
    if (hipMemsetAsync((char*)d_ws + WS_BAR, 0, 16384, stream) != hipSuccess) { fprintf(stderr, "kernel_launch: memset failed\n"); return; }
    Params p{};
    for (int i = 0; i < 29; ++i) p.in[i] = (const float*)d_in[i];
    p.out = (float*)d_out; p.ws = (unsigned char*)d_ws;
#if N_LAUNCH_PER_PHASE
    for (int ph = 0; ph < NPHASE; ++ph) { p.ph_lo = ph; p.ph_hi = ph + 1; void* args[] = {&p};
        hipLaunchCooperativeKernel((void*)fwd_megakernel, dim3(grid_blocks), dim3(512), args, LDS_BYTES, stream); }
#else
    p.ph_lo = 0; p.ph_hi = NPHASE; void* args[] = {&p};
    hipError_t e = hipLaunchCooperativeKernel((void*)fwd_megakernel, dim3(grid_blocks), dim3(512), args, LDS_BYTES, stream);
    if (e != hipSuccess) fprintf(stderr, "cooperative launch failed: %s (grid %d)\n", hipGetErrorString(e), grid_blocks);
#endif
}
```
